# Optimizing an MI355X kernel written in HIP

```python
import jax, jax.numpy as jnp
from jax import lax
import numpy as np

D_MODEL = 1024
BATCH = 8
SEQ = 2048
DEPTH = 1
DEC_BATCH = 4
DEC_SEQ = 4096
PAST_LEN = 128

N_META = 16
EPS = 1e-6
D_FF = 2816
SSD_D_INNER = D_MODEL
SSD_HEADDIM = 64
SSD_HEADS = SSD_D_INNER // SSD_HEADDIM
SSD_GROUPS = 4
SSD_STATE = 128
SSD_CONV = 5
SSD_CHUNK = 128
SSD_GN = SSD_GROUPS * SSD_STATE
SSD_CONV_DIM = SSD_D_INNER + 2 * SSD_GN
HG_WIDTH = D_MODEL
HG_HEADDIM = 128
HG_HEADS = HG_WIDTH // HG_HEADDIM
HG_CHUNK = 64
IN_WIDTHS = (SSD_D_INNER, SSD_CONV_DIM, 2 * SSD_HEADS, HG_WIDTH, 2 * HG_WIDTH, HG_WIDTH, HG_WIDTH, 2 * D_MODEL)
IN_COLS = sum(IN_WIDTHS)

kernel_name = 'hybrid_ssd_hgrn2_bidir_encoder'


def _split_points(widths):
    pts, acc = [], 0
    for w in widths[:-1]:
        acc += w
        pts.append(acc)
    return pts


def rmsnorm(x, w):
    xf = x.astype(jnp.float32)
    y = xf * lax.rsqrt(jnp.mean(xf * xf, axis=-1, keepdims=True) + EPS)
    return (y * w.astype(jnp.float32)).astype(x.dtype)


def swiglu(h, w_gate_up, w_down):
    g, u = jnp.split(h @ w_gate_up, 2, axis=-1)
    return (jax.nn.silu(g) * u) @ w_down


def _pad_front(u, n):
    return jnp.pad(u, [(0, 0), (n, 0)] + [(0, 0)] * (u.ndim - 2))


def _flip(u):
    return jnp.flip(u, axis=1)


def depthwise_conv_centred(u, w, bias):
    c = u.shape[-1]
    y = lax.conv_general_dilated(u, w.reshape(SSD_CONV, 1, c), window_strides=(1,),
                                 padding=[(SSD_CONV // 2, SSD_CONV // 2)],
                                 dimension_numbers=('NWC', 'WIO', 'NWC'), feature_group_count=c)
    return y + bias


def ssd_chunked(x, dt, A, Bm, Cm):
    b, T, H, P = x.shape
    G, N = Bm.shape[2], Bm.shape[3]
    Hg = H // G
    Q = SSD_CHUNK
    c = T // Q
    acs = jnp.cumsum((dt * A).reshape(b, c, Q, G, Hg), axis=2)
    xdt = (x * dt[..., None]).reshape(b, c, Q, G, Hg, P)
    Bc = Bm.reshape(b, c, Q, G, N)
    Cc = Cm.reshape(b, c, Q, G, N)
    mask = jnp.tril(jnp.ones((Q, Q), dtype=bool))[:, :, None, None]
    seg = acs[:, :, :, None] - acs[:, :, None, :]
    Lm = jnp.exp(jnp.where(mask, seg, -jnp.inf))
    CB = jnp.einsum('bctgn,bcsgn->bctsg', Cc, Bc)
    y_diag = jnp.einsum('bctsg,bctsgh,bcsghp->bctghp', CB, Lm, xdt)
    decay_to_end = jnp.exp(acs[:, :, -1:] - acs)
    states = jnp.einsum('bcsgn,bcsgh,bcsghp->bcghpn', Bc, decay_to_end, xdt)
    chunk_decay = jnp.exp(acs[:, :, -1])

    def step(h, inp):
        st, dec = inp
        return dec[..., None, None] * h + st, h

    h0 = jnp.zeros((b, G, Hg, P, N), x.dtype)
    _, prev = lax.scan(step, h0, (jnp.moveaxis(states, 1, 0), jnp.moveaxis(chunk_decay, 1, 0)))
    prev = jnp.moveaxis(prev, 0, 1)
    y_off = jnp.einsum('bctgn,bcghpn,bctgh->bctghp', Cc, prev, jnp.exp(acs))
    return (y_diag + y_off).reshape(b, T, H, P)


def hgrn2_chunked(q, k, v, logf):
    b, T, H, K = q.shape
    V = v.shape[-1]
    Q = HG_CHUNK
    c = T // Q
    q = q.reshape(b, c, Q, H, K)
    k = k.reshape(b, c, Q, H, K)
    v = v.reshape(b, c, Q, H, V)
    bcs = jnp.cumsum(logf.reshape(b, c, Q, H, K), axis=2)
    ref = bcs[:, :, Q // 2:Q // 2 + 1]
    qe = q * jnp.exp(bcs - ref)
    ke = k * jnp.exp(ref - bcs)
    mask = jnp.tril(jnp.ones((Q, Q), dtype=bool))
    A = jnp.where(mask, jnp.einsum('bcthk,bcshk->bchts', qe, ke), 0.0)
    o_intra = jnp.einsum('bchts,bcshv->bcthv', A, v)
    kv = jnp.einsum('bcshk,bcshv->bchkv', k * jnp.exp(bcs[:, :, -1:] - bcs), v)
    chunk_decay = jnp.exp(bcs[:, :, -1])

    def step(S, inp):
        upd, dec = inp
        return dec[..., None] * S + upd, S

    S0 = jnp.zeros((b, H, K, V), q.dtype)
    _, prev = lax.scan(step, S0, (jnp.moveaxis(kv, 1, 0), jnp.moveaxis(chunk_decay, 1, 0)))
    prev = jnp.moveaxis(prev, 0, 1)
    o_inter = jnp.einsum('bcthk,bchkv->bcthv', q * jnp.exp(bcs), prev)
    return (o_intra + o_inter).reshape(b, T, H, V)


def ssd_branch(z, xbc, dt_raw, conv_w, conv_b, dt_bias, a_log, d_skip, norm_w):
    f32 = jnp.float32
    b, L, _ = xbc.shape
    xbc = jax.nn.silu(depthwise_conv_centred(xbc.astype(f32), conv_w.astype(f32), conv_b.astype(f32)))
    xs = xbc[..., :SSD_D_INNER].reshape(b, L, SSD_HEADS, SSD_HEADDIM)
    Bm = xbc[..., SSD_D_INNER:SSD_D_INNER + SSD_GN].reshape(b, L, SSD_GROUPS, SSD_STATE)
    Cm = xbc[..., SSD_D_INNER + SSD_GN:].reshape(b, L, SSD_GROUPS, SSD_STATE)
    dt = jax.nn.softplus(dt_raw.astype(f32).reshape(b, L, 2, SSD_HEADS) + dt_bias.astype(f32))
    A = -jnp.exp(a_log.astype(f32))
    npad = SSD_CHUNK - N_META
    xp, Bp, Cp, dtp = (_pad_front(u, npad) for u in (xs, Bm, Cm, dt))
    y_fwd = ssd_chunked(xp, dtp[:, :, 0], A[0], Bp, Cp)
    y_bwd = _flip(ssd_chunked(_flip(xp), _flip(dtp[:, :, 1]), A[1], _flip(Bp), _flip(Cp)))
    y = (y_fwd + y_bwd)[:, npad:] + d_skip.astype(f32)[:, None] * xs
    y = y.reshape(b, L, SSD_D_INNER) * jax.nn.silu(z.astype(f32))
    return rmsnorm(y, norm_w)


def hgrn2_branch(hq, hf, hi, hg, lb, norm_w):
    f32 = jnp.float32
    b, L, _ = hq.shape
    q = jax.nn.silu(hq.astype(f32)).reshape(b, L, HG_HEADS, HG_HEADDIM)
    v = hi.astype(f32).reshape(b, L, HG_HEADS, HG_HEADDIM)
    lbf = lb.astype(f32).reshape(2, HG_HEADS, HG_HEADDIM)
    f = lbf + (1.0 - lbf) * jax.nn.sigmoid(hf.astype(f32).reshape(b, L, 2, HG_HEADS, HG_HEADDIM))
    k = 1.0 - f
    logf = jnp.log(f)
    npad = HG_CHUNK - N_META
    qp, vp, kp, lfp = (_pad_front(u, npad) for u in (q, v, k, logf))
    o_fwd = hgrn2_chunked(qp, kp[:, :, 0], vp, lfp[:, :, 0])
    o_bwd = _flip(hgrn2_chunked(_flip(qp), _flip(kp[:, :, 1]), _flip(vp), _flip(lfp[:, :, 1])))
    o = (o_fwd + o_bwd)[:, npad:]
    o = o * lax.rsqrt(jnp.mean(o * o, axis=-1, keepdims=True) + EPS) * norm_w.astype(f32).reshape(HG_HEADS, HG_HEADDIM)
    return o.reshape(b, L, HG_WIDTH) * jax.nn.silu(hg.astype(f32))


def hybrid_mixer(h, w_in, conv_w, conv_b, dt_bias, a_log, d_skip, ssd_norm, ssd_w_proj,
                 lb, hg_norm, hg_w_proj, w_out):
    proj = h @ w_in
    z, xbc, dt_raw, hq, hf, hi, hg, gates = jnp.split(proj, _split_points(IN_WIDTHS), axis=-1)
    branch_a = ssd_branch(z, xbc, dt_raw, conv_w, conv_b, dt_bias, a_log, d_skip, ssd_norm) @ ssd_w_proj
    branch_b = hgrn2_branch(hq, hf, hi, hg, lb, hg_norm) @ hg_w_proj
    ga, gb = jnp.split(jax.nn.sigmoid(gates.astype(jnp.float32)), 2, axis=-1)
    merged = ga * branch_a + gb * branch_b
    return (merged @ w_out).astype(h.dtype)


def encoder_trunk(x, meta_tokens, ffn1_norm, ffn1_w_gate_up, ffn1_w_down, mix_norm, w_in,
                  ssd_conv_w, ssd_conv_b, ssd_dt_bias, ssd_a_log, ssd_d, ssd_norm, ssd_w_proj,
                  hg_lb_table, hg_norm, hg_w_proj, w_out, ffn2_norm, ffn2_w_gate_up, ffn2_w_down,
                  final_norm):
    b = x.shape[0]
    meta = jnp.broadcast_to(meta_tokens[None].astype(x.dtype), (b, N_META, x.shape[-1]))
    h = jnp.concatenate([meta, x], axis=1)
    lb_all = jnp.cumsum(jax.nn.softmax(hg_lb_table.astype(jnp.float32), axis=1), axis=1)
    for l in range(DEPTH):
        h = h + 0.5 * swiglu(rmsnorm(h, ffn1_norm[l]), ffn1_w_gate_up[l], ffn1_w_down[l])
        h = h + hybrid_mixer(rmsnorm(h, mix_norm[l]), w_in[l], ssd_conv_w[l], ssd_conv_b[l],
                             ssd_dt_bias[l], ssd_a_log[l], ssd_d[l], ssd_norm[l], ssd_w_proj[l],
                             lb_all[:, l], hg_norm[l], hg_w_proj[l], w_out[l])
        h = h + 0.5 * swiglu(rmsnorm(h, ffn2_norm[l]), ffn2_w_gate_up[l], ffn2_w_down[l])
    return rmsnorm(h, final_norm)[:, N_META:]


def setup_inputs(seed: int = 0) -> dict:
    key = jax.random.key(seed)
    ks = jax.random.split(key, 26)
    nrm = lambda k, shape, scale: jax.random.normal(k, shape, jnp.float32) * scale
    gain = lambda k, shape: 1.0 + 0.05 * jax.random.normal(k, shape, jnp.float32)
    dt0 = jnp.exp(jax.random.uniform(ks[0], (DEPTH, 2, SSD_HEADS), jnp.float32, np.log(1e-3), np.log(1e-1)))
    return {
        'x_prompt': nrm(ks[1], (BATCH, SEQ, D_MODEL), 1.0),
        'x_sample': nrm(ks[2], (DEC_BATCH, DEC_SEQ, D_MODEL), 1.0),
        'meta_tokens': nrm(ks[3], (N_META, D_MODEL), 1.0),
        'ffn1_norm': gain(ks[4], (DEPTH, D_MODEL)),
        'ffn1_w_gate_up': nrm(ks[5], (DEPTH, D_MODEL, 2 * D_FF), D_MODEL ** -0.5),
        'ffn1_w_down': nrm(ks[6], (DEPTH, D_FF, D_MODEL), D_FF ** -0.5),
        'mix_norm': gain(ks[7], (DEPTH, D_MODEL)),
        'w_in': nrm(ks[8], (DEPTH, D_MODEL, IN_COLS), D_MODEL ** -0.5),
        'ssd_conv_w': nrm(ks[9], (DEPTH, SSD_CONV, SSD_CONV_DIM), SSD_CONV ** -0.5),
        'ssd_conv_b': nrm(ks[10], (DEPTH, SSD_CONV_DIM), 0.02),
        'ssd_dt_bias': dt0 + jnp.log(-jnp.expm1(-dt0)),
        'ssd_a_log': jnp.log(jax.random.uniform(ks[11], (DEPTH, 2, SSD_HEADS), jnp.float32, 1.0, 16.0)),
        'ssd_d': gain(ks[12], (DEPTH, SSD_HEADS)),
        'ssd_norm': gain(ks[13], (DEPTH, SSD_D_INNER)),
        'ssd_w_proj': nrm(ks[14], (DEPTH, SSD_D_INNER, D_MODEL), SSD_D_INNER ** -0.5),
        'hg_lb_table': nrm(ks[15], (2, DEPTH + 1, HG_WIDTH), 0.1),
        'hg_norm': gain(ks[16], (DEPTH, HG_WIDTH)),
        'hg_w_proj': nrm(ks[17], (DEPTH, HG_WIDTH, D_MODEL), HG_WIDTH ** -0.5),
        'w_out': nrm(ks[18], (DEPTH, D_MODEL, D_MODEL), D_MODEL ** -0.5),
        'ffn2_norm': gain(ks[19], (DEPTH, D_MODEL)),
        'ffn2_w_gate_up': nrm(ks[20], (DEPTH, D_MODEL, 2 * D_FF), D_MODEL ** -0.5),
        'ffn2_w_down': nrm(ks[21], (DEPTH, D_FF, D_MODEL), D_FF ** -0.5),
        'final_norm': gain(ks[22], (D_MODEL,)),
    }


def reference(x_prompt, x_sample, meta_tokens, ffn1_norm, ffn1_w_gate_up, ffn1_w_down, mix_norm, w_in,
              ssd_conv_w, ssd_conv_b, ssd_dt_bias, ssd_a_log, ssd_d, ssd_norm, ssd_w_proj,
              hg_lb_table, hg_norm, hg_w_proj, w_out, ffn2_norm, ffn2_w_gate_up, ffn2_w_down, final_norm):
    y_prompt = encoder_trunk(x_prompt, meta_tokens, ffn1_norm, ffn1_w_gate_up, ffn1_w_down, mix_norm, w_in,
                             ssd_conv_w, ssd_conv_b, ssd_dt_bias, ssd_a_log, ssd_d, ssd_norm, ssd_w_proj,
                             hg_lb_table, hg_norm, hg_w_proj, w_out, ffn2_norm, ffn2_w_gate_up, ffn2_w_down,
                             final_norm)
    y_sample = encoder_trunk(x_sample, meta_tokens, ffn1_norm, ffn1_w_gate_up, ffn1_w_down, mix_norm, w_in,
                             ssd_conv_w, ssd_conv_b, ssd_dt_bias, ssd_a_log, ssd_d, ssd_norm, ssd_w_proj,
                             hg_lb_table, hg_norm, hg_w_proj, w_out, ffn2_norm, ffn2_w_gate_up, ffn2_w_down,
                             final_norm)
    return (y_prompt, y_sample)
```

```cpp
#include <hip/hip_runtime.h>
#include <hip/hip_cooperative_groups.h>
#include <cstdio>
#include <cstdint>
namespace cg = cooperative_groups;

#ifndef STAGE
#define STAGE 99
#endif

#define LAS __attribute__((address_space(3)))
typedef unsigned short bf16_t;
typedef short bf16x8 __attribute__((ext_vector_type(8)));
typedef float f32x4 __attribute__((ext_vector_type(4)));
typedef unsigned u32x4 __attribute__((ext_vector_type(4)));

constexpr int DM = 1024, DFF = 2816, NTOK = 32768, NP_ROWS = 16384;
constexpr int GROUP_ROWS = 8192, NGROUPS = 4;
constexpr float EPS = 1e-6f;
constexpr int IN_COLS = 10272;
constexpr int NPRE = 6144, NPOST = 4096;

constexpr size_t MiB = 1u << 20;
constexpr size_t WS_SS0 = 0, WS_SS1 = 128 * 1024, WS_SS2 = 256 * 1024, WS_SS3 = 384 * 1024, WS_SSM0 = 512 * 1024, WS_SSM1 = 512 * 1024 + 256, WS_LBV = 520 * 1024;
constexpr size_t WS_BAR = 640 * 1024;
constexpr size_t WS_META = 1 * MiB;
constexpr size_t M_HBM = WS_META, M_ACTM = WS_META + 32 * 1024, M_XBCM = WS_META + 128 * 1024, M_QM = WS_META + 192 * 1024, M_LOGFM = WS_META + 224 * 1024,
                 M_VM = WS_META + 288 * 1024, M_DTM = WS_META + 320 * 1024, M_XCM = WS_META + 324 * 1024;
constexpr size_t WS_DT = 3 * MiB;
constexpr size_t WS_WGU1 = 7 * MiB, WS_WD1 = 18 * MiB, WS_WGU2 = 23 * MiB + 512 * 1024, WS_WD2 = 34 * MiB + 512 * 1024, WS_WPRE = 40 * MiB, WS_WPOST = 52 * MiB,
                 WS_WA = 60 * MiB, WS_WB = 62 * MiB, WS_WOUT = 64 * MiB, WS_WDT = 66 * MiB;
constexpr size_t WS_HB = 67 * MiB;
constexpr size_t WS_F = 131 * MiB;
constexpr size_t WS_QB = WS_F, WS_VB = WS_F + 16 * MiB, WS_ZG = WS_F + 32 * MiB, WS_GATES = WS_F + 64 * MiB;
constexpr size_t WS_QE1 = 227 * MiB, WS_HSC = 243 * MiB;
constexpr size_t WS_END = 256 * MiB;
constexpr size_t DO_Y = 0, DO_XC = 32 * MiB, DO_LOGF = 64 * MiB, DO_OF = 96 * MiB, DO_OB = 112 * MiB;

__device__ __forceinline__ unsigned f2bf(float f) { unsigned u = __builtin_bit_cast(unsigned, f); return (u + 0x7fffu + ((u >> 16) & 1u)) >> 16; }
typedef float f32x2_t __attribute__((ext_vector_type(2)));
typedef __bf16 bf16x2_t __attribute__((ext_vector_type(2)));
__device__ __forceinline__ unsigned pk2(float lo, float hi) { const f32x2_t v = {lo, hi}; const bf16x2_t b = __builtin_convertvector(v, bf16x2_t); return __builtin_bit_cast(unsigned, b); }
__device__ __forceinline__ float bflo(unsigned w) { return __builtin_bit_cast(float, w << 16); }
__device__ __forceinline__ float bfhi(unsigned w) { return __builtin_bit_cast(float, w & 0xffff0000u); }
__device__ __forceinline__ float bf2f(bf16_t h) { return __builtin_bit_cast(float, ((unsigned)h) << 16); }
__device__ __forceinline__ float frcp(float x) { return __builtin_amdgcn_rcpf(x); }
__device__ __forceinline__ float fsigmoid(float x) { return frcp(1.f + __expf(-x)); }
__device__ __forceinline__ float fsilu(float x) { return x * frcp(1.f + __expf(-x)); }
__device__ __forceinline__ unsigned pkh2(float lo, float hi) { _Float16 a = (_Float16)lo, b = (_Float16)hi; return (unsigned)__builtin_bit_cast(unsigned short, a) | ((unsigned)__builtin_bit_cast(unsigned short, b) << 16); }
__device__ __forceinline__ float hlo(unsigned w) { return (float)__builtin_bit_cast(_Float16, (unsigned short)(w & 0xffffu)); }
__device__ __forceinline__ float hhi(unsigned w) { return (float)__builtin_bit_cast(_Float16, (unsigned short)(w >> 16)); }
__device__ __forceinline__ int fresh_tid() { int t = threadIdx.x; asm volatile("" : "+v"(t)); return t; }
__device__ __forceinline__ float wave_sum(float v) {
#pragma unroll
    for (int o = 1; o < 64; o <<= 1) v += __shfl_xor(v, o);
    return v;
}
template <int CTRL, int RM> __device__ __forceinline__ float dppmov(float v) { return __builtin_bit_cast(float, __builtin_amdgcn_update_dpp(0, __builtin_bit_cast(int, v), CTRL, RM, 0xf, false)); }
__device__ __forceinline__ float wave_scan(float v, int) {
    v += dppmov<0x111, 0xf>(v); v += dppmov<0x112, 0xf>(v); v += dppmov<0x114, 0xf>(v); v += dppmov<0x118, 0xf>(v);
    v += dppmov<0x142, 0xa>(v); v += dppmov<0x143, 0xc>(v);
    return v;
}
__device__ __forceinline__ float lane_bcast(float v, int l) { return __builtin_bit_cast(float, __builtin_amdgcn_readlane(__builtin_bit_cast(int, v), l)); }
__device__ __forceinline__ void unpack8(const u32x4 w, float (&f)[8]) {
    f[0] = bflo(w.x); f[1] = bfhi(w.x); f[2] = bflo(w.y); f[3] = bfhi(w.y); f[4] = bflo(w.z); f[5] = bfhi(w.z); f[6] = bflo(w.w); f[7] = bfhi(w.w);
}
__device__ __forceinline__ u32x4 pack8(const float (&f)[8]) { u32x4 w; w.x = pk2(f[0], f[1]); w.y = pk2(f[2], f[3]); w.z = pk2(f[4], f[5]); w.w = pk2(f[6], f[7]); return w; }

namespace pg8 {
#define PG8_LAS __attribute__((address_space(3)))
constexpr int BM = 256, BK = 64, HALF = 128, HTB = HALF * BK * 2, STAGE_BYTES = 8 * HTB, NXCD = 8, WGM = 8;
__host__ __device__ __forceinline__ int lds_byte(int r, int c) { const int st = (r >> 4) * 2 + (c >> 5), rr = r & 15, cc = c & 31, ob = rr * 64 + cc * 2; return st * 1024 + (ob ^ (((ob >> 9) & 1) << 5)); }
__host__ __device__ __forceinline__ void stage_rc(int b, int& R, int& C) { const int st = b / 1024, sb = b % 1024, swz = sb ^ (((sb >> 9) & 1) << 5); R = (st >> 1) * 16 + swz / 64; C = (st & 1) * 32 + (swz % 64) / 2; }
__host__ __device__ __forceinline__ int perm32(int rho) { const int n = rho >> 4, i = rho & 15; return 8 * (i >> 2) + 4 * n + (i & 3); }
struct Unit { int pm, pn; };
struct Gemm { const bf16_t* A; const bf16_t* Bt; int M, N, K; };
struct StaticOrder {
    int nM, nN, nwg, G, c;
    __device__ void init(int M, int N, int G_, int c_) { nM = M / BM; nN = N / BM; nwg = nM * nN; G = G_; c = c_; }
    __device__ bool next(int i, Unit& u) const {
        if (c < 0) return false;
        const long L = (long)i * G + c; if (L >= nwg) return false;
        int wgid = (int)L; { const int q = nwg / NXCD, r = nwg % NXCD, xcd = wgid % NXCD, off = wgid / NXCD; wgid = (xcd < r ? xcd * (q + 1) : r * (q + 1) + (xcd - r) * q) + off; }
        const int nig = WGM * nN, gid = wgid / nig, fm = gid * WGM, gsz = (nM - fm) < WGM ? (nM - fm) : WGM;
        u.pm = fm + ((wgid % nig) % gsz); u.pn = (wgid % nig) / gsz; return true;
    }
    __device__ __forceinline__ void a_ready(const Unit&) const {}
    __device__ __forceinline__ void done(const Unit&) const {}
};

template <class Epi, class Sched, bool ALIGN_EPI = false, bool SP2 = false>
__device__ __forceinline__ void gemm_phase(PG8_LAS unsigned char* lds, const Gemm g, const Sched& S, const Epi& E) {
    const int tid = fresh_tid(), wid = __builtin_amdgcn_readfirstlane(tid >> 6), lane = tid & 63, wr = wid >> 2, wc = wid & 3, fr = lane & 15, fq = lane >> 4;
    const int K = g.K, nt = K / BK;
    unsigned voffA[2], voffB[2];
#pragma unroll
    for (int i = 0; i < 2; ++i) { int R, C; stage_rc(tid * 16 + i * 8192, R, C); const int Rb = Epi::PERM ? ((R & ~31) + perm32(R & 31)) : R;
        voffA[i] = (unsigned)(R * K + C) * 2u; voffB[i] = (unsigned)(Rb * K + C) * 2u; }
    const size_t kstep = (size_t)(BK * 2);
    const size_t hstep = (size_t)HALF * K * 2;
    const size_t tstep = 2 * hstep;
    const unsigned ldsw = (unsigned)wid * 1024u;
    const int aoff = lds_byte(wr * 64 + fr, fq * 8), boff = lds_byte(wc * 32 + fr, fq * 8);
#define PG8_SA(b, h) (((b) * 2 + (h)) * HTB)
#define PG8_SB(b, h) ((4 + (b) * 2 + (h)) * HTB)
#define PG8_STAGE(bufoff, gbase, voff) do { _Pragma("unroll") for (int _i = 0; _i < 2; ++_i) \
        __builtin_amdgcn_global_load_lds((const unsigned*)((const char*)(gbase) + (voff)[_i]), (PG8_LAS unsigned*)(lds + (bufoff) + ldsw + _i * 8192), 16, 0, 0); } while (0)
#define PG8_LDA(dst, b, h) do { _Pragma("unroll") for (int m = 0; m < 4; ++m) _Pragma("unroll") for (int k = 0; k < 2; ++k) dst[m][k] = *(const PG8_LAS bf16x8*)(lds + PG8_SA(b, h) + aoff + m * 2048 + k * 1024); } while (0)
#define PG8_LDB(dst, b, h) do { _Pragma("unroll") for (int n = 0; n < 2; ++n) _Pragma("unroll") for (int k = 0; k < 2; ++k) dst[n][k] = *(const PG8_LAS bf16x8*)(lds + PG8_SB(b, h) + boff + n * 2048 + k * 1024); } while (0)
#define PG8_MMA(ai, bj, At, Bt) do { __builtin_amdgcn_s_setprio(1); _Pragma("unroll") for (int m = 0; m < 4; ++m) _Pragma("unroll") for (int n = 0; n < 2; ++n) _Pragma("unroll") for (int k = 0; k < 2; ++k) \
        acc[ai][bj][m][n] = __builtin_amdgcn_mfma_f32_16x16x32_bf16(Bt[n][k], At[m][k], acc[ai][bj][m][n], 0, 0, 0); __builtin_amdgcn_s_setprio(0); } while (0)
#define PG8_WAIT_V(n) asm volatile("s_waitcnt vmcnt(" #n ")" ::: "memory")
#define PG8_WAIT_L(n) asm volatile("s_waitcnt lgkmcnt(" #n ")" ::: "memory")
#define PG8_BAR __builtin_amdgcn_s_barrier()
#define PG8_SCHED __builtin_amdgcn_sched_barrier(0)
    Unit cur, nxt; int ui = 0;
    if (!S.next(0, cur)) return;
    f32x4 acc[2][2][4][2];
#pragma unroll
    for (int a = 0; a < 2; ++a)
#pragma unroll
        for (int b = 0; b < 2; ++b)
#pragma unroll
            for (int m = 0; m < 4; ++m)
#pragma unroll
                for (int n = 0; n < 2; ++n) acc[a][b][m][n] = (f32x4){0.f, 0.f, 0.f, 0.f};
    bf16x8 At[4][2], B0[2][2], B1[2][2];
    const char* cA = (const char*)g.A + (size_t)cur.pm * tstep; const char* cB = (const char*)g.Bt + (size_t)cur.pn * tstep;
    S.a_ready(cur);
    if constexpr (SP2) {
        PG8_STAGE(PG8_SB(0, 0), cB, voffB); PG8_STAGE(PG8_SB(0, 1), cB + hstep, voffB); PG8_STAGE(PG8_SA(0, 0), cA, voffA); PG8_STAGE(PG8_SA(0, 1), cA + hstep, voffA);
        if (wr == 1) PG8_BAR;
        PG8_WAIT_V(2); PG8_BAR;
        PG8_STAGE(PG8_SB(1, 0), cB + kstep, voffB); PG8_STAGE(PG8_SA(1, 0), cA + kstep, voffA); PG8_STAGE(PG8_SB(1, 1), cB + hstep + kstep, voffB);
        PG8_WAIT_V(6); PG8_BAR;
    } else {
        PG8_STAGE(PG8_SB(0, 0), cB, voffB); PG8_STAGE(PG8_SA(0, 0), cA, voffA); PG8_STAGE(PG8_SB(0, 1), cB + hstep, voffB); PG8_STAGE(PG8_SA(0, 1), cA + hstep, voffA);
        if (wr == 1) PG8_BAR;
        PG8_WAIT_V(4); PG8_BAR;
        PG8_STAGE(PG8_SB(1, 0), cB + kstep, voffB); PG8_STAGE(PG8_SA(1, 0), cA + kstep, voffA); PG8_STAGE(PG8_SB(1, 1), cB + hstep + kstep, voffB);
        PG8_WAIT_V(6); PG8_BAR;
    }
    for (;;) {
        const bool has_next = S.next(ui + 1, nxt);
        const char* nA = has_next ? (const char*)g.A + (size_t)nxt.pm * tstep : cA; const char* nB = has_next ? (const char*)g.Bt + (size_t)nxt.pn * tstep : cB;
        for (int t = 0; t < nt; t += 2) {
            const bool last = (t == nt - 2);
            const char* a1 = cA + (size_t)(t + 1) * kstep;
            const char* a2 = last ? nA : cA + (size_t)(t + 2) * kstep; const char* b2 = last ? nB : cB + (size_t)(t + 2) * kstep;
            const char* a3 = a2 + kstep; const char* b3 = b2 + kstep;
            if (last && has_next) S.a_ready(nxt);
            if constexpr (SP2) {
            PG8_LDB(B0, 0, 0); PG8_LDB(B1, 0, 1); PG8_SCHED; PG8_LDA(At, 0, 0); PG8_STAGE(PG8_SA(1, 1), a1 + hstep, voffA);
            PG8_WAIT_V(8); PG8_WAIT_L(0); PG8_BAR; PG8_MMA(0, 0, At, B0); PG8_MMA(0, 1, At, B1); PG8_BAR; PG8_SCHED;
            PG8_LDA(At, 0, 1); PG8_STAGE(PG8_SB(0, 0), b2, voffB); PG8_STAGE(PG8_SB(0, 1), b2 + hstep, voffB); PG8_STAGE(PG8_SA(0, 0), a2, voffA);
            PG8_WAIT_V(8); PG8_WAIT_L(0); PG8_BAR; PG8_MMA(1, 0, At, B0); PG8_MMA(1, 1, At, B1); PG8_BAR; PG8_SCHED;
            PG8_LDB(B0, 1, 0); PG8_LDB(B1, 1, 1); PG8_SCHED; PG8_LDA(At, 1, 0); PG8_STAGE(PG8_SA(0, 1), a2 + hstep, voffA);
            PG8_WAIT_V(8); PG8_WAIT_L(0); PG8_BAR; PG8_MMA(0, 0, At, B0); PG8_MMA(0, 1, At, B1); PG8_BAR; PG8_SCHED;
            PG8_LDA(At, 1, 1); PG8_STAGE(PG8_SB(1, 0), b3, voffB); PG8_STAGE(PG8_SB(1, 1), b3 + hstep, voffB); PG8_STAGE(PG8_SA(1, 0), a3, voffA);
            PG8_WAIT_V(8); PG8_WAIT_L(0); PG8_BAR; PG8_MMA(1, 0, At, B0); PG8_MMA(1, 1, At, B1); PG8_BAR; PG8_SCHED;
            } else {
            PG8_LDB(B0, 0, 0); PG8_SCHED; PG8_LDA(At, 0, 0); PG8_STAGE(PG8_SA(1, 1), a1 + hstep, voffA);
            PG8_WAIT_L(8); PG8_BAR; PG8_WAIT_L(0); PG8_MMA(0, 0, At, B0); PG8_BAR; PG8_SCHED;
            PG8_LDB(B1, 0, 1); PG8_STAGE(PG8_SB(0, 0), b2, voffB);
            PG8_BAR; PG8_WAIT_L(0); PG8_MMA(0, 1, At, B1); PG8_BAR;
            PG8_LDA(At, 0, 1); PG8_STAGE(PG8_SA(0, 0), a2, voffA);
            PG8_BAR; PG8_WAIT_L(0); PG8_MMA(1, 0, At, B0); PG8_BAR; PG8_SCHED;
            PG8_STAGE(PG8_SB(0, 1), b2 + hstep, voffB);
            PG8_WAIT_V(6); PG8_BAR; PG8_MMA(1, 1, At, B1); PG8_BAR;
            PG8_LDB(B0, 1, 0); PG8_SCHED; PG8_LDA(At, 1, 0); PG8_STAGE(PG8_SA(0, 1), a2 + hstep, voffA);
            PG8_WAIT_L(8); PG8_BAR; PG8_WAIT_L(0); PG8_MMA(0, 0, At, B0); PG8_BAR; PG8_SCHED;
            PG8_LDB(B1, 1, 1); PG8_STAGE(PG8_SB(1, 0), b3, voffB);
            PG8_BAR; PG8_WAIT_L(0); PG8_MMA(0, 1, At, B1); PG8_BAR;
            PG8_LDA(At, 1, 1); PG8_STAGE(PG8_SA(1, 0), a3, voffA);
            PG8_BAR; PG8_WAIT_L(0); PG8_MMA(1, 0, At, B0); PG8_BAR; PG8_SCHED;
            PG8_STAGE(PG8_SB(1, 1), b3 + hstep, voffB);
            PG8_WAIT_V(6); PG8_BAR; PG8_MMA(1, 1, At, B1); PG8_BAR;
            }
        }
        if constexpr (ALIGN_EPI) { if (wr == 0) PG8_BAR; }
        E(acc, cur, wr, wc, fr, fq); S.done(cur);
        if (!has_next) break;
#pragma unroll
        for (int a = 0; a < 2; ++a)
#pragma unroll
            for (int b = 0; b < 2; ++b)
#pragma unroll
                for (int m = 0; m < 4; ++m)
#pragma unroll
                    for (int n = 0; n < 2; ++n) acc[a][b][m][n] = (f32x4){0.f, 0.f, 0.f, 0.f};
        cur = nxt; cA = nA; cB = nB; ++ui;
        if constexpr (ALIGN_EPI) { if (wr == 1) PG8_BAR; }
    }
    PG8_WAIT_V(0);
    if constexpr (!ALIGN_EPI) { if (wr == 0) PG8_BAR; }
    PG8_BAR;
#undef PG8_SA
#undef PG8_SB
#undef PG8_STAGE
#undef PG8_LDA
#undef PG8_LDB
#undef PG8_MMA
#undef PG8_WAIT_V
#undef PG8_WAIT_L
#undef PG8_BAR
#undef PG8_SCHED
}

typedef f32x4 Acc[2][2][4][2];

struct EpiGU {
    static constexpr bool PERM = true;
    bf16_t* act0; bf16_t* act1; int split_row; const float* ss; int row_base;
    __device__ __forceinline__ void operator()(const Acc& acc, const Unit& u, int wr, int wc, int fr, int fq) const {
        const int row0 = row_base + u.pm * BM + wr * 64 + fr, col = u.pn * 128 + wc * 32 + 8 * fq;
#pragma unroll
        for (int ai = 0; ai < 2; ++ai)
#pragma unroll
            for (int m = 0; m < 4; ++m) {
                const int r = row0 + ai * HALF + m * 16;
                const float s = __builtin_amdgcn_rsqf(ss[r] * (1.f / DM) + EPS);
                bf16_t* dst = (r < split_row ? act0 + (size_t)r * DFF : act1 + (size_t)(r - split_row) * DFF) + col;
                float o[8];
#pragma unroll
                for (int n = 0; n < 2; ++n)
#pragma unroll
                    for (int i = 0; i < 4; ++i) { const float g = acc[ai][0][m][n][i] * s, up = acc[ai][1][m][n][i] * s; o[4 * n + i] = fsilu(g) * up; }
                *(u32x4*)dst = pack8(o);
            }
    }
};

template <int RES  , int OUT  >
struct EpiRes {
    static constexpr bool PERM = true;
    const float* xp; const float* xs; bf16_t* hb; float* outf; float alpha; float* ss_out; int row_base;
    __device__ __forceinline__ void operator()(const Acc& acc, const Unit& u, int wr, int wc, int fr, int fq) const {
        const int row0 = row_base + u.pm * BM + wr * 64 + fr, col0 = u.pn * BM + wc * 32 + 8 * fq;
#pragma unroll
        for (int ai = 0; ai < 2; ++ai)
#pragma unroll
            for (int m = 0; m < 4; ++m) {
                const int r = row0 + ai * HALF + m * 16; float sq = 0.f;
#pragma unroll
                for (int bj = 0; bj < 2; ++bj) {
                    const int c = col0 + bj * HALF; float res[8], v[8];
                    if (RES == 0) { const float* xr = (r < NP_ROWS ? xp + (size_t)r * DM : xs + (size_t)(r - NP_ROWS) * DM) + c; const f32x4 a = *(const f32x4*)xr, b = *(const f32x4*)(xr + 4);
                        res[0] = a[0]; res[1] = a[1]; res[2] = a[2]; res[3] = a[3]; res[4] = b[0]; res[5] = b[1]; res[6] = b[2]; res[7] = b[3]; }
                    else { const u32x4 w = *(const u32x4*)(hb + (size_t)r * DM + c); unpack8(w, res); }
#pragma unroll
                    for (int n = 0; n < 2; ++n)
#pragma unroll
                        for (int i = 0; i < 4; ++i) { const float t = res[4 * n + i] + alpha * acc[ai][bj][m][n][i]; v[4 * n + i] = t; sq += t * t; }
                    if (OUT == 0) *(u32x4*)(hb + (size_t)r * DM + c) = pack8(v);
                    else { float* o = outf + (size_t)r * DM + c; *(f32x4*)o = (f32x4){v[0], v[1], v[2], v[3]}; *(f32x4*)(o + 4) = (f32x4){v[4], v[5], v[6], v[7]}; }
                }
                sq += __shfl_xor(sq, 16); sq += __shfl_xor(sq, 32);
                if (fq == 0) atomicAdd(ss_out + r, sq);
            }
    }
};

struct EpiPre {
    static constexpr bool PERM = true;
    bf16_t* xbc; bf16_t* q; bf16_t* logf; bf16_t* v; const float* ss; const float* lbv; int grow0;
    __device__ __forceinline__ void operator()(const Acc& acc, const Unit& u, int wr, int wc, int fr, int fq) const {
        const int row0 = u.pm * BM + wr * 64 + fr, pn = u.pn;
        int mode, ld, cb; bf16_t* base;
        if (pn < 8) { mode = 0; base = xbc; ld = 2048; cb = pn * 256; }
        else if (pn < 12) { mode = 1; base = q; ld = 1024; cb = (pn - 8) * 256; }
        else if (pn < 20) { mode = 2; base = logf; ld = 2048; cb = (pn - 12) * 256; }
        else { mode = 0; base = v; ld = 1024; cb = (pn - 20) * 256; }
        const int col0 = cb + wc * 32 + 8 * fq;
#pragma unroll
        for (int ai = 0; ai < 2; ++ai)
#pragma unroll
            for (int m = 0; m < 4; ++m) {
                const int r = row0 + ai * HALF + m * 16;
                const float s = __builtin_amdgcn_rsqf(ss[grow0 + r] * (1.f / DM) + EPS);
#pragma unroll
                for (int bj = 0; bj < 2; ++bj) {
                    const int c = col0 + bj * HALF; float o[8];
#pragma unroll
                    for (int n = 0; n < 2; ++n)
#pragma unroll
                        for (int i = 0; i < 4; ++i) o[4 * n + i] = acc[ai][bj][m][n][i] * s;
                    u32x4 w;
                    if (mode == 0) w = pack8(o);
                    else if (mode == 1) {
#pragma unroll
                        for (int i = 0; i < 8; ++i) o[i] = fsilu(o[i]);
                        w = pack8(o);
                    } else {
                        const f32x4 l0 = *(const f32x4*)(lbv + c), l1 = *(const f32x4*)(lbv + c + 4);
                        const float lb[8] = {l0[0], l0[1], l0[2], l0[3], l1[0], l1[1], l1[2], l1[3]};
#pragma unroll
                        for (int i = 0; i < 8; ++i) { const float f = lb[i] + (1.f - lb[i]) * fsigmoid(o[i]); o[i] = __logf(f); }
                        w.x = pkh2(o[0], o[1]); w.y = pkh2(o[2], o[3]); w.z = pkh2(o[4], o[5]); w.w = pkh2(o[6], o[7]);
                    }
                    *(u32x4*)(base + (size_t)r * ld + c) = w;
                }
            }
    }
};

struct EpiPost {
    static constexpr bool PERM = true;
    bf16_t* zg; bf16_t* gates; const float* ss; int grow0;
    __device__ __forceinline__ void operator()(const Acc& acc, const Unit& u, int wr, int wc, int fr, int fq) const {
        const int row0 = u.pm * BM + wr * 64 + fr, pn = u.pn;
        const bool isg = pn >= 8; bf16_t* base = isg ? gates : zg; const int col0 = (isg ? pn - 8 : pn) * 256 + wc * 32 + 8 * fq;
#pragma unroll
        for (int ai = 0; ai < 2; ++ai)
#pragma unroll
            for (int m = 0; m < 4; ++m) {
                const int r = row0 + ai * HALF + m * 16;
                const float s = __builtin_amdgcn_rsqf(ss[grow0 + r] * (1.f / DM) + EPS);
#pragma unroll
                for (int bj = 0; bj < 2; ++bj) {
                    const int c = col0 + bj * HALF; float o[8];
#pragma unroll
                    for (int n = 0; n < 2; ++n)
#pragma unroll
                        for (int i = 0; i < 4; ++i) { const float t = acc[ai][bj][m][n][i] * s; o[4 * n + i] = isg ? fsigmoid(t) : fsilu(t); }
                    *(u32x4*)(base + (size_t)r * 2048 + c) = pack8(o);
                }
            }
    }
};

template <int FIRST>
struct EpiMerge {
    static constexpr bool PERM = true;
    bf16_t* merged; const bf16_t* gates;
    __device__ __forceinline__ void operator()(const Acc& acc, const Unit& u, int wr, int wc, int fr, int fq) const {
        const int row0 = u.pm * BM + wr * 64 + fr, col0 = u.pn * BM + wc * 32 + 8 * fq;
#pragma unroll
        for (int ai = 0; ai < 2; ++ai)
#pragma unroll
            for (int m = 0; m < 4; ++m) {
                const int r = row0 + ai * HALF + m * 16;
#pragma unroll
                for (int bj = 0; bj < 2; ++bj) {
                    const int c = col0 + bj * HALF; float gt[8], o[8];
                    unpack8(*(const u32x4*)(gates + (size_t)r * 2048 + (FIRST ? 0 : 1024) + c), gt);
                    if (FIRST) {
#pragma unroll
                        for (int i = 0; i < 8; ++i) o[i] = 0.f;
                    } else unpack8(*(const u32x4*)(merged + (size_t)r * DM + c), o);
#pragma unroll
                    for (int n = 0; n < 2; ++n)
#pragma unroll
                        for (int i = 0; i < 4; ++i) o[4 * n + i] += gt[4 * n + i] * acc[ai][bj][m][n][i];
                    *(u32x4*)(merged + (size_t)r * DM + c) = pack8(o);
                }
            }
    }
};
}

__device__ __forceinline__ f32x4 sg16(const bf16_t* A, int lda, const bf16_t* Bt, int K, int lane) {
    const int r = lane & 15, q = lane >> 4;
    const bf16_t* ap = A + (size_t)r * lda + q * 8; const bf16_t* bp = Bt + (size_t)r * K + q * 8;
    f32x4 acc = {0.f, 0.f, 0.f, 0.f};
    for (int k = 0; k < K; k += 256) {
        bf16x8 a[8], b[8];
#pragma unroll
        for (int u = 0; u < 8; ++u) { a[u] = *(const bf16x8*)(ap + k + 32 * u); b[u] = *(const bf16x8*)(bp + k + 32 * u); }
#pragma unroll
        for (int u = 0; u < 8; ++u) acc = __builtin_amdgcn_mfma_f32_16x16x32_bf16(a[u], b[u], acc, 0, 0, 0);
    }
    return acc;
}

__device__ __forceinline__ void tr_item(const float* W, int N, int K, int n0, int k0, bf16_t* WT, int drow, const float* scale, LAS float* scr, int lane) {
#pragma unroll 8
    for (int i = 0; i < 32; ++i) { const int kk = 2 * i + (lane >> 5); float v = W[(size_t)(k0 + kk) * N + n0 + (lane & 31)]; if (scale) v *= scale[k0 + kk]; scr[kk * 33 + (lane & 31)] = v; }
    asm volatile("s_waitcnt lgkmcnt(0)" ::: "memory");
    const int c = lane & 7;
#pragma unroll
    for (int j = 0; j < 4; ++j) { const int n = (lane >> 3) + 8 * j; const LAS float* s = scr + (8 * c) * 33 + n;
        u32x4 o; o.x = pk2(s[0 * 33], s[1 * 33]); o.y = pk2(s[2 * 33], s[3 * 33]); o.z = pk2(s[4 * 33], s[5 * 33]); o.w = pk2(s[6 * 33], s[7 * 33]);
        *(u32x4*)(WT + (size_t)(drow + n) * K + k0 + 8 * c) = o; }
    asm volatile("s_waitcnt lgkmcnt(0)" ::: "memory");
}
__device__ __forceinline__ void tr_job(const float* W, int N, int K, int c0, int nc, bf16_t* WT, int d0, int mode, const float* scale, LAS float* scr, int gw, int ngw, int lane) {
    const int nblk = nc / 32, nitems = (K / 64) * nblk;
    for (int it = gw; it < nitems; it += ngw) {
        const int kb = it / nblk, nb = it % nblk, n0 = 32 * nb; int drow;
        if (mode == 0) drow = d0 + n0;
        else { const int j = n0 < DFF ? n0 : n0 - DFF; drow = (j / 128) * 256 + (j % 128) + (n0 < DFF ? 0 : 128); }
        tr_item(W, N, K, c0 + n0, 64 * kb, WT, drow, scale, scr, lane);
    }
}

constexpr int B_X1 = 0, B_X2 = 17408, B_VA = 35840, B_VB = 46080, B_ACS = 56320, B_R = 56576, B_C1 = 56832, B_C2 = 57344, B_E = 57856, BUFSZ = 58368;
constexpr int L_M = 2 * BUFSZ, L_S = L_M + 9216, L_OUT = L_S + 17408, SCAN_LDS_END = L_OUT + 9216;
constexpr int P136 = 136, P144 = 144, P80 = 80, P72 = 72;
typedef short v4i16_t __attribute__((ext_vector_type(4)));

#define LDF(base, row, col, pitch) (*(const LAS bf16x8*)(lds + (base) + ((row) * (pitch) + (col)) * 2))
__device__ __forceinline__ bf16x8 trfrag(LAS unsigned char* lds, int base, int pitch, int c, int ks, int lane) {
    const int g = lane >> 4, q = (lane & 15) >> 2, p = lane & 3;
    const int off = base + ((32 * ks + 8 * g + q) * pitch + 16 * c + 4 * p) * 2;
    const v4i16_t v0 = __builtin_amdgcn_ds_read_tr16_b64_v4i16((LAS v4i16_t*)(lds + off));
    const v4i16_t v1 = __builtin_amdgcn_ds_read_tr16_b64_v4i16((LAS v4i16_t*)(lds + off + 8 * pitch));
    return __builtin_shufflevector(v0, v1, 0, 1, 2, 3, 4, 5, 6, 7);
}

struct ScanItem {
    int kind;
    int head, dir, vh, nC;
    int row0;
    int grow0;
    const bf16_t* xc; const bf16_t* xcm; const float* dt; const float* dtm; float Aneg;
    const bf16_t* q; const bf16_t* logf; const bf16_t* v; const bf16_t* logfm; const bf16_t* vm; const float* hsc;
    bf16_t* out;
    int ocol;
};

template <int KIND>
__device__ __forceinline__ void scan_run(LAS unsigned char* lds, const ScanItem& it) {
    const int tid = fresh_tid(), lane = tid & 63, wv = __builtin_amdgcn_readfirstlane(tid >> 6), fr = lane & 15, fq = lane >> 4;
    const int nSteps = it.nC + (it.dir == 0 ? 1 : 0);
    const int tr = wv >> 1, tc0 = (wv & 1) * 2, nt0 = (wv & 1) * 4;
    const int r0 = tid >> 4, ch = tid & 15, rxr = tid >> 3, xch = tid & 7;
    f32x4 S[4];
#pragma unroll
    for (int i = 0; i < 4; ++i) S[i] = (f32x4){0.f, 0.f, 0.f, 0.f};
    u32x4 ra[2], rb[2], rx; float dtv = 0.f, sc1 = 0.f, sc2 = 0.f, sce = 0.f;
    const u32x4 Z4 = {0u, 0u, 0u, 0u};

#define SCAN_LOAD(st) do { \
        const bool meta = (it.dir == 0 && (st) == 0); \
        const int c = it.dir == 0 ? (st) - 1 : it.nC - 1 - (st); \
        if (meta) { \
            if (KIND == 0) { const int cb = (it.head >> 2) * 128 + 8 * ch; \
                ra[0] = Z4; rb[0] = Z4; rx = Z4; ra[1] = Z4; rb[1] = Z4; dtv = 0.f; \
                if (r0 < 16) { ra[0] = *(const u32x4*)(it.xcm + (size_t)r0 * 2048 + 1536 + cb); rb[0] = *(const u32x4*)(it.xcm + (size_t)r0 * 2048 + 1024 + cb); } \
                if (rxr < 16) rx = *(const u32x4*)(it.xcm + (size_t)rxr * 2048 + it.head * 64 + 8 * xch); \
                if (lane < 16) dtv = it.dtm[lane * 32 + it.head]; } \
            else { ra[0] = Z4; ra[1] = Z4; rb[0] = Z4; rb[1] = Z4; rx = Z4; \
                if (lane < 16) { rb[0] = *(const u32x4*)(it.logfm + (size_t)lane * 2048 + it.head * 128 + 8 * wv); rb[1] = *(const u32x4*)(it.logfm + (size_t)lane * 2048 + it.head * 128 + 8 * (wv + 8)); \
                    rx = *(const u32x4*)(it.vm + (size_t)lane * 1024 + it.head * 128 + it.vh * 64 + 8 * wv); } } \
        } else { \
            const size_t g0 = (size_t)(it.row0 + 64 * c + (it.dir == 0 ? r0 : 63 - r0)), g1 = (size_t)(it.row0 + 64 * c + (it.dir == 0 ? r0 + 32 : 31 - r0)), gx = (size_t)(it.row0 + 64 * c + (it.dir == 0 ? rxr : 63 - rxr)); \
            if (KIND == 0) { const int cb = (it.head >> 2) * 128 + 8 * ch; \
                ra[0] = *(const u32x4*)(it.xc + g0 * 2048 + 1536 + cb); ra[1] = *(const u32x4*)(it.xc + g1 * 2048 + 1536 + cb); \
                rb[0] = *(const u32x4*)(it.xc + g0 * 2048 + 1024 + cb); rb[1] = *(const u32x4*)(it.xc + g1 * 2048 + 1024 + cb); \
                rx = *(const u32x4*)(it.xc + gx * 2048 + it.head * 64 + 8 * xch); \
                dtv = it.dt[(size_t)(it.grow0 + 64 * c + (it.dir == 0 ? lane : 63 - lane)) * 32 + it.dir * 16 + it.head]; } \
            else { const int cq = it.head * 128 + 8 * ch; \
                ra[0] = *(const u32x4*)(it.q + g0 * 1024 + cq); ra[1] = *(const u32x4*)(it.q + g1 * 1024 + cq); \
                rb[0] = *(const u32x4*)(it.logf + g0 * 2048 + it.dir * 1024 + cq); rb[1] = *(const u32x4*)(it.logf + g1 * 2048 + it.dir * 1024 + cq); \
                rx = *(const u32x4*)(it.v + gx * 1024 + it.head * 128 + it.vh * 64 + 8 * xch); \
                if (tid < 128) { const float* hp = it.hsc + (size_t)(it.row0 / 64 + c) * 6144 + it.dir * 1024 + it.head * 128 + tid; sc1 = hp[0]; sc2 = hp[2048]; sce = hp[4096]; } } \
        } } while (0)

#define SCAN_PREP(bo) do { \
        if (KIND == 0) { \
            const float a_ = dtv * it.Aneg; const float acs = wave_scan(a_, lane); const float aend = lane_bcast(acs, 63); \
            *(LAS u32x4*)(lds + (bo) + B_X1 + (r0 * P136 + 8 * ch) * 2) = ra[0]; *(LAS u32x4*)(lds + (bo) + B_X1 + ((r0 + 32) * P136 + 8 * ch) * 2) = ra[1]; \
            *(LAS u32x4*)(lds + (bo) + B_X2 + (r0 * P144 + 8 * ch) * 2) = rb[0]; *(LAS u32x4*)(lds + (bo) + B_X2 + ((r0 + 32) * P144 + 8 * ch) * 2) = rb[1]; \
            const int srcl = 8 * wv + (lane >> 3); \
            const float dtr = __shfl(dtv, srcl), acr = __shfl(acs, srcl), dte = __expf(aend - acr); \
            float x_[8], xe_[8]; unpack8(rx, x_); \
            _Pragma("unroll") for (int e = 0; e < 8; ++e) { x_[e] *= dtr; xe_[e] = x_[e] * dte; } \
            *(LAS u32x4*)(lds + (bo) + B_VA + (rxr * P80 + 8 * xch) * 2) = pack8(x_); \
            *(LAS u32x4*)(lds + (bo) + B_VB + (rxr * P80 + 8 * xch) * 2) = pack8(xe_); \
            if (wv == 0) { *(LAS float*)(lds + (bo) + B_ACS + lane * 4) = acs; *(LAS float*)(lds + (bo) + B_R + lane * 4) = __expf(acs); } \
            if (wv == 1 || wv == 2) { const int n_ = (wv - 1) * 64 + lane; *(LAS float*)(lds + (bo) + B_C1 + n_ * 4) = __expf(aend); *(LAS float*)(lds + (bo) + B_C2 + n_ * 4) = 1.f; *(LAS float*)(lds + (bo) + B_E + n_ * 4) = 1.f; } \
        } else { \
            *(LAS u32x4*)(lds + (bo) + B_X1 + (r0 * P136 + 8 * ch) * 2) = ra[0]; *(LAS u32x4*)(lds + (bo) + B_X1 + ((r0 + 32) * P136 + 8 * ch) * 2) = ra[1]; \
            *(LAS u32x4*)(lds + (bo) + B_X2 + (r0 * P144 + 8 * ch) * 2) = rb[0]; *(LAS u32x4*)(lds + (bo) + B_X2 + ((r0 + 32) * P144 + 8 * ch) * 2) = rb[1]; \
            *(LAS u32x4*)(lds + (bo) + B_VA + (rxr * P80 + 8 * xch) * 2) = rx; \
            if (tid < 128) { *(LAS float*)(lds + (bo) + B_C1 + tid * 4) = sc1; *(LAS float*)(lds + (bo) + B_C2 + tid * 4) = sc2; *(LAS float*)(lds + (bo) + B_E + tid * 4) = sce; } \
        } } while (0)

    bool pend = false; int pc = 0;
#define SCAN_FLUSH() do { if (pend) { const int _r = tid >> 3, _sg = tid & 7; const u32x4 _v = *(const LAS u32x4*)(lds + L_OUT + (_r * P72 + 8 * _sg) * 2); \
        const int _lr = it.dir == 0 ? _r : 63 - _r; *(u32x4*)(it.out + (size_t)(it.row0 + 64 * pc + _lr) * 1024 + it.ocol + 8 * _sg) = _v; } } while (0)

    SCAN_LOAD(0);
    if (KIND == 1 && it.dir == 0) {
#pragma unroll
        for (int i = 0; i < 2; ++i) { const int cv = wv + 8 * i;
            float lf[8], ke[8];
            lf[0] = hlo(rb[i].x); lf[1] = hhi(rb[i].x); lf[2] = hlo(rb[i].y); lf[3] = hhi(rb[i].y); lf[4] = hlo(rb[i].z); lf[5] = hhi(rb[i].z); lf[6] = hlo(rb[i].w); lf[7] = hhi(rb[i].w);
#pragma unroll
            for (int e = 0; e < 8; ++e) {
                const float b = wave_scan(lf[e], lane); const float ref = lane_bcast(b, 31), tot = lane_bcast(b, 63);
                ke[e] = (1.f - __expf(lf[e])) * __expf(ref - b);
                if (lane == 0) { *(LAS float*)(lds + B_C1 + (8 * cv + e) * 4) = __expf(tot); *(LAS float*)(lds + B_C2 + (8 * cv + e) * 4) = __expf(tot - ref); *(LAS float*)(lds + B_E + (8 * cv + e) * 4) = __expf(ref); }
            }
            *(LAS u32x4*)(lds + B_X1 + (lane * P136 + 8 * cv) * 2) = Z4;
            *(LAS u32x4*)(lds + B_X2 + (lane * P144 + 8 * cv) * 2) = pack8(ke);
        }
        *(LAS u32x4*)(lds + B_VA + (lane * P80 + 8 * wv) * 2) = rx;
    } else SCAN_PREP(0);
    if (nSteps > 1) SCAN_LOAD(1);

    for (int st = 0; st < nSteps; ++st) {
        const int bo = (st & 1) * BUFSZ;
        const bool do_out = !(it.dir == 0 && st == 0);
        __syncthreads();
#pragma unroll
        for (int i = 0; i < 4; ++i) { const int n = 16 * (nt0 + i) + fr; const float e = *(const LAS float*)(lds + bo + B_E + n * 4);
#pragma unroll
            for (int j = 0; j < 4; j += 2) { const unsigned w = pk2(S[i][j] * e, S[i][j + 1] * e);
                *(LAS bf16_t*)(lds + L_S + ((16 * tr + 4 * fq + j) * P136 + n) * 2) = (bf16_t)(w & 0xffffu); *(LAS bf16_t*)(lds + L_S + ((16 * tr + 4 * fq + j + 1) * P136 + n) * 2) = (bf16_t)(w >> 16); } }
        bf16x8 xa[4];
        if (do_out) {
            f32x4 g0 = {0.f, 0.f, 0.f, 0.f}, g1 = {0.f, 0.f, 0.f, 0.f};
#pragma unroll
            for (int kk = 0; kk < 4; ++kk) { xa[kk] = LDF(bo + B_X1, 16 * tr + fr, 32 * kk + 8 * fq, P136); const bf16x8 b0 = LDF(bo + B_X2, 16 * tc0 + fr, 32 * kk + 8 * fq, P144), b1 = LDF(bo + B_X2, 16 * (tc0 + 1) + fr, 32 * kk + 8 * fq, P144);
                g0 = __builtin_amdgcn_mfma_f32_16x16x32_bf16(xa[kk], b0, g0, 0, 0, 0); g1 = __builtin_amdgcn_mfma_f32_16x16x32_bf16(xa[kk], b1, g1, 0, 0, 0); }
#pragma unroll
            for (int h = 0; h < 2; ++h) { const int s = 16 * (tc0 + h) + fr; float as = 0.f; if (KIND == 0) as = *(const LAS float*)(lds + bo + B_ACS + s * 4);
                float gm[4];
#pragma unroll
                for (int j = 0; j < 4; ++j) { const int t = 16 * tr + 4 * fq + j; float g = h ? g1[j] : g0[j];
                    if (KIND == 0) { const float at = *(const LAS float*)(lds + bo + B_ACS + t * 4); g *= __expf(fminf(at - as, 0.f)); }
                    gm[j] = (s <= t) ? g : 0.f; }
#pragma unroll
                for (int j = 0; j < 4; j += 2) { const int t = 16 * tr + 4 * fq + j; const unsigned w = pk2(gm[j], gm[j + 1]);
                    *(LAS bf16_t*)(lds + L_M + (t * P72 + s) * 2) = (bf16_t)(w & 0xffffu); *(LAS bf16_t*)(lds + L_M + ((t + 1) * P72 + s) * 2) = (bf16_t)(w >> 16); } }
        }
        SCAN_FLUSH();
        __syncthreads();
        if (do_out) {
            f32x4 z0 = {0.f, 0.f, 0.f, 0.f}, z1 = {0.f, 0.f, 0.f, 0.f};
#pragma unroll
            for (int kk = 0; kk < 4; ++kk) { const bf16x8 b0 = LDF(L_S, 16 * tc0 + fr, 32 * kk + 8 * fq, P136), b1 = LDF(L_S, 16 * (tc0 + 1) + fr, 32 * kk + 8 * fq, P136);
                z0 = __builtin_amdgcn_mfma_f32_16x16x32_bf16(xa[kk], b0, z0, 0, 0, 0); z1 = __builtin_amdgcn_mfma_f32_16x16x32_bf16(xa[kk], b1, z1, 0, 0, 0); }
            if (KIND == 0) {
#pragma unroll
                for (int j = 0; j < 4; ++j) { const float r = *(const LAS float*)(lds + bo + B_R + (16 * tr + 4 * fq + j) * 4); z0[j] *= r; z1[j] *= r; } }
#pragma unroll
            for (int kk = 0; kk < 2; ++kk) { const bf16x8 a = LDF(L_M, 16 * tr + fr, 32 * kk + 8 * fq, P72), b0 = trfrag(lds, bo + B_VA, P80, tc0, kk, lane), b1 = trfrag(lds, bo + B_VA, P80, tc0 + 1, kk, lane);
                z0 = __builtin_amdgcn_mfma_f32_16x16x32_bf16(a, b0, z0, 0, 0, 0); z1 = __builtin_amdgcn_mfma_f32_16x16x32_bf16(a, b1, z1, 0, 0, 0); }
#pragma unroll
            for (int j = 0; j < 4; ++j) { const int t = 16 * tr + 4 * fq + j; const unsigned w = pk2(z0[j], z1[j]);
                *(LAS bf16_t*)(lds + L_OUT + (t * P72 + 16 * tc0 + fr) * 2) = (bf16_t)(w & 0xffffu); *(LAS bf16_t*)(lds + L_OUT + (t * P72 + 16 * (tc0 + 1) + fr) * 2) = (bf16_t)(w >> 16); }
        }
        pend = do_out; pc = it.dir == 0 ? st - 1 : it.nC - 1 - st;
        {
            f32x4 d[4];
#pragma unroll
            for (int i = 0; i < 4; ++i) d[i] = (f32x4){0.f, 0.f, 0.f, 0.f};
#pragma unroll
            for (int kk = 0; kk < 2; ++kk) { const bf16x8 a = trfrag(lds, bo + (KIND == 0 ? B_VB : B_VA), P80, tr, kk, lane);
#pragma unroll
                for (int i = 0; i < 4; ++i) { const bf16x8 b = trfrag(lds, bo + B_X2, P144, nt0 + i, kk, lane); d[i] = __builtin_amdgcn_mfma_f32_16x16x32_bf16(a, b, d[i], 0, 0, 0); } }
#pragma unroll
            for (int i = 0; i < 4; ++i) { const int n = 16 * (nt0 + i) + fr; const float c1 = *(const LAS float*)(lds + bo + B_C1 + n * 4), c2 = *(const LAS float*)(lds + bo + B_C2 + n * 4);
#pragma unroll
                for (int j = 0; j < 4; ++j) S[i][j] = c1 * S[i][j] + c2 * d[i][j]; }
        }
        if (st + 1 < nSteps) { SCAN_PREP(BUFSZ - bo); if (st + 2 < nSteps) SCAN_LOAD(st + 2); }
    }
    __syncthreads();
    SCAN_FLUSH();
    __syncthreads();
#undef SCAN_FLUSH
#undef SCAN_PREP
#undef SCAN_LOAD
}

#define XB_TMO      128
#define XB_XCNT(j)  (256  + 64 * (j))
#define XB_XSUB(j)  (1280 + 64 * (j))
#define XB_XGEN(j)  (2304 + 64 * (j))
#define XB_TOP      3328
#define XB_TOPGEN   3392
#define XCD_BAR_WORDS 3456
#define XB_SPIN_CAP (1u << 22)
__device__ __forceinline__ unsigned xb_ld(unsigned* p)              { return __hip_atomic_load(p, __ATOMIC_RELAXED, __HIP_MEMORY_SCOPE_AGENT); }
__device__ __forceinline__ unsigned xb_add(unsigned* p, unsigned v) { return __hip_atomic_fetch_add(p, v, __ATOMIC_RELAXED, __HIP_MEMORY_SCOPE_AGENT); }
__device__ __forceinline__ unsigned xb_xcc_id() { return (unsigned)__builtin_amdgcn_s_getreg((3 << 11) | 20) & 0xFu; }
#define XB_SPIN(cond, bar) do { unsigned _sp = 0; while (cond) { __builtin_amdgcn_s_sleep(1); \
    if ((++_sp & 255u) == 0u) { if (xb_ld(&(bar)[XB_TMO])) break; if (_sp > XB_SPIN_CAP) { atomicAdd(&(bar)[XB_TMO], 1u); break; } } } } while (0)
struct XcdBarrier { unsigned* bar; unsigned x; volatile LAS unsigned* st; };
__device__ __forceinline__ XcdBarrier xcd_barrier_post(unsigned* bar, volatile LAS unsigned* st) {
    XcdBarrier b; b.bar = bar; b.x = xb_xcc_id(); b.st = st;
    if (threadIdx.x == 0) (void)xb_add(&bar[XB_XCNT(b.x)], 1u);
    return b;
}
__device__ __forceinline__ void xcd_barrier_complete(unsigned* bar, unsigned x, unsigned& nloc, unsigned& nx) {
    const unsigned G = gridDim.x * gridDim.y * gridDim.z;
    unsigned sum, cnt, mine, sp = 0u;
    for (;;) {
        sum = 0u; cnt = 0u; mine = 0u;
#pragma unroll
        for (unsigned j = 0; j < 16; ++j) { const unsigned c = xb_ld(&bar[XB_XCNT(j)]); sum += c; cnt += (c > 0u) ? 1u : 0u; mine = (j == x) ? c : mine; }
        if (sum == G) break;
        __builtin_amdgcn_s_sleep(1);
        if ((++sp & 255u) == 0u) { if (xb_ld(&bar[XB_TMO])) break; if (sp > XB_SPIN_CAP) { atomicAdd(&bar[XB_TMO], 1u); break; } }
    }
    nloc = mine > 0u ? mine : 1u; nx = cnt > 0u ? cnt : 1u;
}
__device__ __forceinline__ void xcd_barrier(const XcdBarrier& b) {
    asm volatile("s_waitcnt vmcnt(0)" ::: "memory");
    __syncthreads();
    if (threadIdx.x == 0) {
        unsigned* bar = b.bar;
        __builtin_amdgcn_s_waitcnt(0);
        unsigned nloc = b.st[0], nx = b.st[1];
        if (nloc == 0u) { xcd_barrier_complete(bar, b.x, nloc, nx); b.st[0] = nloc; b.st[1] = nx; }
        const unsigned old = xb_add(&bar[XB_XSUB(b.x)], 1u);
        const unsigned gen = old / nloc;
        if (old + 1u == (gen + 1u) * nloc) {
            __builtin_amdgcn_fence(__ATOMIC_RELEASE, "agent");
            asm volatile("s_waitcnt vmcnt(0)" ::: "memory");
            const unsigned og = xb_add(&bar[XB_TOP], 1u);
            const unsigned tg = og / nx;
            if (og + 1u == (tg + 1u) * nx) xb_add(&bar[XB_TOPGEN], 1u);
            else XB_SPIN(xb_ld(&bar[XB_TOPGEN]) == tg, bar);
            __builtin_amdgcn_fence(__ATOMIC_ACQUIRE, "agent");
            xb_add(&bar[XB_XGEN(b.x)], 1u);
            asm volatile("s_waitcnt vmcnt(0)" ::: "memory");
        } else {
            XB_SPIN(xb_ld(&bar[XB_XGEN(b.x)]) == gen, bar);
            __builtin_amdgcn_fence(__ATOMIC_ACQUIRE, "agent");
            asm volatile("s_waitcnt vmcnt(0)" ::: "memory");
        }
    }
    __syncthreads();
}

struct Params { const float* in[23]; float* out; unsigned char* ws; };

constexpr int LDS_BST = 152576;
constexpr int LDS_BYTES = 152832;

__global__ void __launch_bounds__(512, 2) fwd_mega(Params P) {
    extern __shared__ __attribute__((aligned(16))) unsigned char lds_raw[];
    LAS unsigned char* lds = (LAS unsigned char*)lds_raw;
    cg::grid_group grid = cg::this_grid();
    const int G = gridDim.x, bx = blockIdx.x;
#define WSD unsigned char* ws = P.ws; asm volatile("" : "+s"(ws)); unsigned char* dob = (unsigned char*)P.out; asm volatile("" : "+s"(dob)); (void)dob
    volatile LAS unsigned* bst = (volatile LAS unsigned*)(lds + LDS_BST);
    if (threadIdx.x < 2) bst[threadIdx.x] = 0u;
    __syncthreads();
    (void)xcd_barrier_post((unsigned*)(P.ws + WS_BAR), bst);
#define GSYNC do { XcdBarrier _xb; _xb.bar = (unsigned*)(P.ws + WS_BAR); _xb.x = xb_xcc_id(); _xb.st = (volatile LAS unsigned*)(lds + LDS_BST); xcd_barrier(_xb); } while (0)
#define IDS WSD; const int tid = fresh_tid(), lane = tid & 63, wave = __builtin_amdgcn_readfirstlane(tid >> 6), gw = bx * 8 + wave, NGW = G * 8, gt = bx * 512 + tid, NGT = G * 512; (void)lane; (void)gw; (void)NGW; (void)gt; (void)NGT
#define x_p (P.in[0])
#define x_s (P.in[1])
#define meta (P.in[2])
#define SS0 ((float*)(ws + WS_SS0))
#define SS1 ((float*)(ws + WS_SS1))
#define SS2 ((float*)(ws + WS_SS2))
#define SS3 ((float*)(ws + WS_SS3))
#define SSM0 ((float*)(ws + WS_SSM0))
#define SSM1 ((float*)(ws + WS_SSM1))
#define LBV ((float*)(ws + WS_LBV))
#define HBM ((bf16_t*)(ws + M_HBM))
#define ACTM ((bf16_t*)(ws + M_ACTM))
#define XBCM ((bf16_t*)(ws + M_XBCM))
#define QM ((bf16_t*)(ws + M_QM))
#define LOGFM ((bf16_t*)(ws + M_LOGFM))
#define VM ((bf16_t*)(ws + M_VM))
#define DTM ((float*)(ws + M_DTM))
#define XCM ((bf16_t*)(ws + M_XCM))
#define DT ((float*)(ws + WS_DT))
#define WGU1 ((bf16_t*)(ws + WS_WGU1))
#define WD1 ((bf16_t*)(ws + WS_WD1))
#define WGU2 ((bf16_t*)(ws + WS_WGU2))
#define WD2 ((bf16_t*)(ws + WS_WD2))
#define WPRE ((bf16_t*)(ws + WS_WPRE))
#define WPOST ((bf16_t*)(ws + WS_WPOST))
#define WA ((bf16_t*)(ws + WS_WA))
#define WB ((bf16_t*)(ws + WS_WB))
#define WOUT ((bf16_t*)(ws + WS_WOUT))
#define WDT ((bf16_t*)(ws + WS_WDT))
#define HB ((bf16_t*)(ws + WS_HB))
#define ACT0 ((bf16_t*)(ws + WS_F))
#define ACT1 ((bf16_t*)dob)
#define QB ((bf16_t*)(ws + WS_QB))
#define VB ((bf16_t*)(ws + WS_VB))
#define ZG ((bf16_t*)(ws + WS_ZG))
#define GATES ((bf16_t*)(ws + WS_GATES))
#define SA QB
#define SB VB
#define XBC ((bf16_t*)(dob + DO_Y))
#define YF ((bf16_t*)(dob + DO_Y))
#define YB ((bf16_t*)(dob + DO_Y + 16 * MiB))
#define XC ((bf16_t*)(dob + DO_XC))
#define LOGF ((bf16_t*)(dob + DO_LOGF))
#define MERGED LOGF
#define OF ((bf16_t*)(dob + DO_OF))
#define OB ((bf16_t*)(dob + DO_OB))
#define QE1 ((bf16_t*)(ws + WS_QE1))
#define HSC ((float*)(ws + WS_HSC))

    {
        IDS;
        LAS float* scr = (LAS float*)(lds + wave * 16384);
        tr_job(P.in[4], 2 * DFF, DM, 0, 2 * DFF, WGU1, 0, 1, P.in[3], scr, gw, NGW, lane);
        tr_job(P.in[5], DM, DFF, 0, DM, WD1, 0, 0, nullptr, scr, gw, NGW, lane);
        tr_job(P.in[20], 2 * DFF, DM, 0, 2 * DFF, WGU2, 0, 1, P.in[19], scr, gw, NGW, lane);
        tr_job(P.in[21], DM, DFF, 0, DM, WD2, 0, 0, nullptr, scr, gw, NGW, lane);
        tr_job(P.in[7], IN_COLS, DM, 1024, 2048, WPRE, 0, 0, P.in[6], scr, gw, NGW, lane);
        tr_job(P.in[7], IN_COLS, DM, 3104, 1024, WPRE, 2048, 0, P.in[6], scr, gw, NGW, lane);
        tr_job(P.in[7], IN_COLS, DM, 4128, 2048, WPRE, 3072, 0, P.in[6], scr, gw, NGW, lane);
        tr_job(P.in[7], IN_COLS, DM, 6176, 1024, WPRE, 5120, 0, P.in[6], scr, gw, NGW, lane);
        tr_job(P.in[7], IN_COLS, DM, 3072, 32, WDT, 0, 0, P.in[6], scr, gw, NGW, lane);
        tr_job(P.in[7], IN_COLS, DM, 0, 1024, WPOST, 0, 0, P.in[6], scr, gw, NGW, lane);
        tr_job(P.in[7], IN_COLS, DM, 7200, 1024, WPOST, 1024, 0, P.in[6], scr, gw, NGW, lane);
        tr_job(P.in[7], IN_COLS, DM, 8224, 2048, WPOST, 2048, 0, P.in[6], scr, gw, NGW, lane);
        tr_job(P.in[14], DM, DM, 0, DM, WA, 0, 0, P.in[13], scr, gw, NGW, lane);
        tr_job(P.in[17], DM, DM, 0, DM, WB, 0, 0, P.in[16], scr, gw, NGW, lane);
        tr_job(P.in[18], DM, DM, 0, DM, WOUT, 0, 0, nullptr, scr, gw, NGW, lane);
        for (int r = gw; r < NTOK + 16; r += NGW) {
            const bool ism = r >= NTOK; const int rr = ism ? r - NTOK : r;
            const float* xr = ism ? meta + (size_t)rr * DM : (rr < NP_ROWS ? x_p + (size_t)rr * DM : x_s + (size_t)(rr - NP_ROWS) * DM);
            bf16_t* orow = ism ? HBM + (size_t)rr * DM : HB + (size_t)rr * DM;
            float s = 0.f;
#pragma unroll
            for (int j = 0; j < 4; ++j) { const f32x4 v = *(const f32x4*)(xr + 4 * lane + 256 * j); s += (v[0] * v[0] + v[1] * v[1]) + (v[2] * v[2] + v[3] * v[3]);
                *(unsigned long long*)(orow + 4 * lane + 256 * j) = (unsigned long long)pk2(v[0], v[1]) | ((unsigned long long)pk2(v[2], v[3]) << 32); }
            s = wave_sum(s);
            if (lane == 0) { if (ism) SSM0[rr] = s; else SS0[rr] = s; }
        }
        for (int i = gt; i < NTOK; i += NGT) { SS1[i] = 0.f; SS2[i] = 0.f; SS3[i] = 0.f; }
        if (gt < 16) SSM1[gt] = 0.f;
        for (int i = gt; i < 2048; i += NGT) { const int d = i >> 10, w = i & 1023; const float* t = P.in[15]; LBV[i] = fsigmoid(t[d * 2048 + w] - t[d * 2048 + 1024 + w]); }
    }
    grid.sync();

    {
        IDS;
        if (gw < 176) {
            const int j0 = 16 * gw, brow = (j0 / 128) * 256 + (j0 % 128);
            const f32x4 ag = sg16(HBM, DM, WGU1 + (size_t)brow * DM, DM, lane), au = sg16(HBM, DM, WGU1 + (size_t)(brow + 128) * DM, DM, lane);
#pragma unroll
            for (int j = 0; j < 4; ++j) { const int row = 4 * (lane >> 4) + j; const float s = __builtin_amdgcn_rsqf(SSM0[row] * (1.f / DM) + EPS);
                ACTM[(size_t)row * DFF + j0 + (lane & 15)] = (bf16_t)f2bf(fsilu(ag[j] * s) * (au[j] * s)); }
        }
        pg8::Gemm g{HB, WGU1, NTOK, 2 * DFF, DM}; pg8::StaticOrder S; S.init(NTOK, 2 * DFF, G, bx);
        pg8::EpiGU E{ACT0, ACT1, NP_ROWS, SS0, 0};
        pg8::gemm_phase<pg8::EpiGU, pg8::StaticOrder, true, true>(lds, g, S, E);
    }
    GSYNC;
    {
        IDS;
        if (gw < 64) {
            const f32x4 a = sg16(ACTM, DFF, WD1 + (size_t)(16 * gw) * DFF, DFF, lane);
#pragma unroll
            for (int j = 0; j < 4; ++j) { const int row = 4 * (lane >> 4) + j, col = 16 * gw + (lane & 15); const float v = meta[(size_t)row * DM + col] + 0.5f * a[j];
                HBM[(size_t)row * DM + col] = (bf16_t)f2bf(v); float sq = v * v; sq += __shfl_xor(sq, 1); sq += __shfl_xor(sq, 2); sq += __shfl_xor(sq, 4); sq += __shfl_xor(sq, 8);
                if ((lane & 15) == 0) atomicAdd(SSM1 + row, sq); }
        }
#pragma unroll 1
        for (int h = 0; h < 2; ++h) {
            pg8::Gemm g{h ? ACT1 : ACT0, WD1, NP_ROWS, DM, DFF}; pg8::StaticOrder S; S.init(NP_ROWS, DM, G, bx);
            pg8::EpiRes<0, 0> E{x_p, x_s, HB, nullptr, 0.5f, SS1, h * NP_ROWS};
            pg8::gemm_phase<pg8::EpiRes<0, 0>, pg8::StaticOrder, true, true>(lds, g, S, E);
        }
    }
    GSYNC;

#if STAGE >= 2
#pragma unroll 1
    for (int grp = 0; grp < NGROUPS; ++grp) {
        const int grow0 = grp * GROUP_ROWS;
        const int nseq = grp < 2 ? 4 : 2, SL = grp < 2 ? 2048 : 4096;
        {
            IDS;
            if (grp == 0) {
                for (int t = gw; t < 384 + 2; t += NGW) {
                    if (t < 384) {
                        const int c0 = 16 * t; const f32x4 a = sg16(HBM, DM, WPRE + (size_t)c0 * DM, DM, lane);
#pragma unroll
                        for (int j = 0; j < 4; ++j) { const int row = 4 * (lane >> 4) + j, c = c0 + (lane & 15); const float v = a[j] * __builtin_amdgcn_rsqf(SSM1[row] * (1.f / DM) + EPS);
                            if (c < 2048) XBCM[row * 2048 + c] = (bf16_t)f2bf(v);
                            else if (c < 3072) QM[row * 1024 + c - 2048] = (bf16_t)f2bf(fsilu(v));
                            else if (c < 5120) { const float lb = LBV[c - 3072]; const float f = lb + (1.f - lb) * fsigmoid(v); LOGFM[row * 2048 + c - 3072] = (bf16_t)(pkh2(__logf(f), 0.f) & 0xffffu); }
                            else VM[row * 1024 + c - 5120] = (bf16_t)f2bf(v); }
                    } else {
                        const int c0 = 16 * (t - 384); const f32x4 a = sg16(HBM, DM, WDT + (size_t)c0 * DM, DM, lane);
#pragma unroll
                        for (int j = 0; j < 4; ++j) { const int row = 4 * (lane >> 4) + j, c = c0 + (lane & 15); const float v = a[j] * __builtin_amdgcn_rsqf(SSM1[row] * (1.f / DM) + EPS) + P.in[10][c];
                            DTM[row * 32 + c] = v > 15.f ? v : log1pf(__expf(v)); }
                    }
                }
            }
            for (int t = gw; t < 1024; t += NGW) {
                const int rt = t >> 1, c0 = 16 * (t & 1), r0 = grow0 + 16 * rt;
                const f32x4 a = sg16(HB + (size_t)r0 * DM, DM, WDT + (size_t)c0 * DM, DM, lane);
#pragma unroll
                for (int j = 0; j < 4; ++j) { const int row = r0 + 4 * (lane >> 4) + j, c = c0 + (lane & 15); const float v = a[j] * __builtin_amdgcn_rsqf(SS1[row] * (1.f / DM) + EPS) + P.in[10][c];
                    DT[(size_t)row * 32 + c] = v > 15.f ? v : log1pf(__expf(v)); }
            }
            pg8::Gemm g{HB + (size_t)grow0 * DM, WPRE, GROUP_ROWS, NPRE, DM}; pg8::StaticOrder S; S.init(GROUP_ROWS, NPRE, G, bx);
            pg8::EpiPre E{XBC, QB, LOGF, VB, SS1, LBV, grow0};
            pg8::gemm_phase<pg8::EpiPre, pg8::StaticOrder, true, true>(lds, g, S, E);
        }
        GSYNC;
        {
            IDS;
            const float* cw = P.in[8]; const float* cb = P.in[9];
#pragma unroll 1
            for (int pass = 0; pass < 2; ++pass) {
            if (((pass ^ (wave >> 2)) & 1) == 0) {
            for (int task = gt; task < (GROUP_ROWS / 16) * 256; task += NGT) {
                const int cgp = task & 255, rb = task >> 8, c = 8 * cgp, t0 = 16 * rb, seq0 = (t0 / SL) * SL, tl0 = t0 - seq0;
                float w[5][8], bias[8];
#pragma unroll
                for (int j = 0; j < 5; ++j) { const f32x4 a = *(const f32x4*)(cw + j * 2048 + c), b = *(const f32x4*)(cw + j * 2048 + c + 4); w[j][0] = a[0]; w[j][1] = a[1]; w[j][2] = a[2]; w[j][3] = a[3]; w[j][4] = b[0]; w[j][5] = b[1]; w[j][6] = b[2]; w[j][7] = b[3]; }
                { const f32x4 a = *(const f32x4*)(cb + c), b = *(const f32x4*)(cb + c + 4); bias[0] = a[0]; bias[1] = a[1]; bias[2] = a[2]; bias[3] = a[3]; bias[4] = b[0]; bias[5] = b[1]; bias[6] = b[2]; bias[7] = b[3]; }
                float win[5][8];
#define CONV_LD(dst, tau) do { const int _t = (tau); u32x4 _w = {0u, 0u, 0u, 0u}; \
                    if (_t < 0) _w = *(const u32x4*)(XBCM + (size_t)(16 + _t) * 2048 + c); else if (_t < SL) _w = *(const u32x4*)(XBC + (size_t)(seq0 + _t) * 2048 + c); \
                    unpack8(_w, dst); } while (0)
                CONV_LD(win[0], tl0 - 2); CONV_LD(win[1], tl0 - 1); CONV_LD(win[2], tl0); CONV_LD(win[3], tl0 + 1);
#pragma unroll
                for (int i = 0; i < 16; ++i) {
                    CONV_LD(win[4], tl0 + i + 2);
                    float o[8];
#pragma unroll
                    for (int e = 0; e < 8; ++e) { float a = bias[e];
#pragma unroll
                        for (int j = 0; j < 5; ++j) a += w[j][e] * win[j][e];
                        o[e] = fsilu(a); }
                    *(u32x4*)(XC + (size_t)(t0 + i) * 2048 + c) = pack8(o);
#pragma unroll
                    for (int j = 0; j < 4; ++j)
#pragma unroll
                        for (int e = 0; e < 8; ++e) win[j][e] = win[j + 1][e];
                }
            }
            for (int task = gt; task < nseq * 16 * 256; task += NGT) {
                const int cgp = task & 255, m = (task >> 8) & 15, sq = task >> 12, c = 8 * cgp, seq0 = sq * SL;
                const int sg = grp < 2 ? grp * 4 + sq : 8 + (grp - 2) * 2 + sq;
                float a[8];
                { const f32x4 b0 = *(const f32x4*)(cb + c), b1 = *(const f32x4*)(cb + c + 4); a[0] = b0[0]; a[1] = b0[1]; a[2] = b0[2]; a[3] = b0[3]; a[4] = b1[0]; a[5] = b1[1]; a[6] = b1[2]; a[7] = b1[3]; }
#pragma unroll
                for (int j = 0; j < 5; ++j) { const int mm = m + j - 2; if (mm < 0) continue;
                    const u32x4 wv_ = mm < 16 ? *(const u32x4*)(XBCM + (size_t)mm * 2048 + c) : *(const u32x4*)(XBC + (size_t)(seq0 + mm - 16) * 2048 + c);
                    float xv[8]; unpack8(wv_, xv); const f32x4 w0 = *(const f32x4*)(cw + j * 2048 + c), w1 = *(const f32x4*)(cw + j * 2048 + c + 4);
                    a[0] += w0[0] * xv[0]; a[1] += w0[1] * xv[1]; a[2] += w0[2] * xv[2]; a[3] += w0[3] * xv[3]; a[4] += w1[0] * xv[4]; a[5] += w1[1] * xv[5]; a[6] += w1[2] * xv[6]; a[7] += w1[3] * xv[7]; }
#pragma unroll
                for (int e = 0; e < 8; ++e) a[e] = fsilu(a[e]);
                *(u32x4*)(XCM + ((size_t)sg * 16 + m) * 2048 + c) = pack8(a);
            }
            } else {
            for (int unit = gw; unit < (GROUP_ROWS / 64) * 128; unit += NGW) {
                const int j = unit & 127, ch = unit >> 7; const size_t row = (size_t)ch * 64 + lane;
                const u32x4 qw = *(const u32x4*)(QB + row * 1024 + 8 * j), l0 = *(const u32x4*)(LOGF + row * 2048 + 8 * j), l1 = *(const u32x4*)(LOGF + row * 2048 + 1024 + 8 * j);
                float qv[8], x0[8], x1[8], qe0[8], ke0[8], qe1[8], ke1[8]; unpack8(qw, qv);
                x0[0] = hlo(l0.x); x0[1] = hhi(l0.x); x0[2] = hlo(l0.y); x0[3] = hhi(l0.y); x0[4] = hlo(l0.z); x0[5] = hhi(l0.z); x0[6] = hlo(l0.w); x0[7] = hhi(l0.w);
                x1[0] = hlo(l1.x); x1[1] = hhi(l1.x); x1[2] = hlo(l1.y); x1[3] = hhi(l1.y); x1[4] = hlo(l1.z); x1[5] = hhi(l1.z); x1[6] = hlo(l1.w); x1[7] = hhi(l1.w);
                float* hs = HSC + (size_t)ch * 6144 + 8 * j; float t0s = 0.f, r0s = 0.f, t1s = 0.f, r1s = 0.f;
#pragma unroll
                for (int e = 0; e < 8; ++e) {
                    const float p0 = wave_scan(x0[e], lane), tot0 = lane_bcast(p0, 63), ref0 = lane_bcast(p0, 31);
                    qe0[e] = qv[e] * __expf(p0 - ref0); ke0[e] = (1.f - __expf(x0[e])) * __expf(ref0 - p0);
                    const float p1 = wave_scan(x1[e], lane), tot1 = lane_bcast(p1, 63), b1 = tot1 - p1 + x1[e], ref1 = lane_bcast(b1, 32);
                    qe1[e] = qv[e] * __expf(b1 - ref1); ke1[e] = (1.f - __expf(x1[e])) * __expf(ref1 - b1);
                    if (lane == e) { t0s = tot0; r0s = ref0; t1s = tot1; r1s = ref1; }
                }
                if (lane < 8) { hs[lane] = __expf(t0s); hs[2048 + lane] = __expf(t0s - r0s); hs[4096 + lane] = __expf(r0s);
                                hs[1024 + lane] = __expf(t1s); hs[2048 + 1024 + lane] = __expf(t1s - r1s); hs[4096 + 1024 + lane] = __expf(r1s); }
                *(u32x4*)(QB + row * 1024 + 8 * j) = pack8(qe0); *(u32x4*)(QE1 + row * 1024 + 8 * j) = pack8(qe1);
                *(u32x4*)(LOGF + row * 2048 + 8 * j) = pack8(ke0); *(u32x4*)(LOGF + row * 2048 + 1024 + 8 * j) = pack8(ke1);
            }
            }
            }
#undef CONV_LD
        }
        GSYNC;
        {
            WSD;
            const int nitems = nseq * 64;
#pragma unroll 1
            for (int item = bx; item < nitems; item += G) {
                ScanItem it; const int half = nseq * 32; it.kind = item / half; const int rem = item % half, sq = rem / 32, r2 = rem % 32;
                const int sg = grp < 2 ? grp * 4 + sq : 8 + (grp - 2) * 2 + sq;
                it.nC = SL / 64; it.row0 = sq * SL; it.grow0 = grow0 + sq * SL;
                it.xc = XC; it.xcm = XCM + (size_t)sg * 16 * 2048; it.dt = DT; it.dtm = DTM; it.q = QB; it.logf = LOGF; it.v = VB; it.logfm = LOGFM; it.vm = VM;
                if (it.kind == 0) { it.head = r2 >> 1; it.dir = r2 & 1; it.vh = 0; it.Aneg = -__expf(P.in[11][it.dir * 16 + it.head]); it.out = it.dir ? YB : YF; it.ocol = it.head * 64;
                    it.dtm = DTM + it.dir * 16; scan_run<0>(lds, it); }
                else { it.head = r2 >> 2; it.dir = (r2 >> 1) & 1; it.vh = r2 & 1; it.Aneg = 0.f; it.out = it.dir ? OB : OF; it.ocol = it.head * 128 + it.vh * 64;
                    it.logfm = LOGFM + it.dir * 1024; it.q = it.dir ? QE1 : QB; it.hsc = HSC; scan_run<1>(lds, it); }
            }
            const int gp = nitems >= G ? G : G - nitems, cp = nitems >= G ? bx : bx - nitems;
            pg8::Gemm g{HB + (size_t)grow0 * DM, WPOST, GROUP_ROWS, NPOST, DM}; pg8::StaticOrder S; S.init(GROUP_ROWS, NPOST, gp, cp);
            pg8::EpiPost E{ZG, GATES, SS1, grow0};
            pg8::gemm_phase<pg8::EpiPost, pg8::StaticOrder, true, true>(lds, g, S, E);
        }
        GSYNC;
        {
            IDS;
            const float* dsk = P.in[12];
            for (int r = gw; r < GROUP_ROWS; r += NGW) {
                float ya[2][8], oa[2][8]; float ssq = 0.f;
#pragma unroll
                for (int j = 0; j < 2; ++j) { const int c = 8 * lane + 512 * j; float yf[8], yb[8], xs[8], zz[8];
                    unpack8(*(const u32x4*)(YF + (size_t)r * 1024 + c), yf); unpack8(*(const u32x4*)(YB + (size_t)r * 1024 + c), yb);
                    unpack8(*(const u32x4*)(XC + (size_t)r * 2048 + c), xs); unpack8(*(const u32x4*)(ZG + (size_t)r * 2048 + c), zz);
                    const float dk = dsk[c >> 6];
#pragma unroll
                    for (int e = 0; e < 8; ++e) { const float v = (yf[e] + yb[e] + dk * xs[e]) * zz[e]; ya[j][e] = v; ssq += v * v; } }
                ssq = wave_sum(ssq); const float rstd = __builtin_amdgcn_rsqf(ssq * (1.f / DM) + EPS);
#pragma unroll
                for (int j = 0; j < 2; ++j) { const int c = 8 * lane + 512 * j; float of[8], ob[8], hg[8]; float hs = 0.f;
                    unpack8(*(const u32x4*)(OF + (size_t)r * 1024 + c), of); unpack8(*(const u32x4*)(OB + (size_t)r * 1024 + c), ob); unpack8(*(const u32x4*)(ZG + (size_t)r * 2048 + 1024 + c), hg);
#pragma unroll
                    for (int e = 0; e < 8; ++e) { const float v = of[e] + ob[e]; oa[j][e] = v; hs += v * v; }
                    hs += __shfl_xor(hs, 1); hs += __shfl_xor(hs, 2); hs += __shfl_xor(hs, 4); hs += __shfl_xor(hs, 8);
                    const float hr = __builtin_amdgcn_rsqf(hs * (1.f / 128.f) + EPS);
#pragma unroll
                    for (int e = 0; e < 8; ++e) oa[j][e] = oa[j][e] * hr * hg[e]; }
#pragma unroll
                for (int j = 0; j < 2; ++j) { const int c = 8 * lane + 512 * j;
#pragma unroll
                    for (int e = 0; e < 8; ++e) ya[j][e] *= rstd;
                    *(u32x4*)(SA + (size_t)r * 1024 + c) = pack8(ya[j]); *(u32x4*)(SB + (size_t)r * 1024 + c) = pack8(oa[j]); }
            }
        }
        GSYNC;
        {
            WSD;
            { pg8::Gemm g{SA, WA, GROUP_ROWS, DM, DM}; pg8::StaticOrder S; S.init(GROUP_ROWS, DM, G, bx); pg8::EpiMerge<1> E{MERGED, GATES};
              pg8::gemm_phase<pg8::EpiMerge<1>, pg8::StaticOrder, true, true>(lds, g, S, E); }
            { pg8::Gemm g{SB, WB, GROUP_ROWS, DM, DM}; pg8::StaticOrder S; S.init(GROUP_ROWS, DM, G, bx); pg8::EpiMerge<0> E{MERGED, GATES};
              pg8::gemm_phase<pg8::EpiMerge<0>, pg8::StaticOrder, true, true>(lds, g, S, E); }
        }
        GSYNC;
        {
            WSD;
            pg8::Gemm g{MERGED, WOUT, GROUP_ROWS, DM, DM}; pg8::StaticOrder S; S.init(GROUP_ROWS, DM, G, bx);
            pg8::EpiRes<1, 0> E{nullptr, nullptr, HB, nullptr, 1.0f, SS2, grow0};
            pg8::gemm_phase<pg8::EpiRes<1, 0>, pg8::StaticOrder, true, true>(lds, g, S, E);
        }
        GSYNC;
    }
#define SSF SS2
#else
#define SSF SS1
#endif

#pragma unroll 1
    for (int h = 0; h < 2; ++h) {
        {
            WSD;
            pg8::Gemm g{HB + (size_t)h * NP_ROWS * DM, WGU2, NP_ROWS, 2 * DFF, DM}; pg8::StaticOrder S; S.init(NP_ROWS, 2 * DFF, G, bx);
            pg8::EpiGU E{ACT0, ACT0, NP_ROWS, SSF, h * NP_ROWS};
            pg8::gemm_phase<pg8::EpiGU, pg8::StaticOrder, true, true>(lds, g, S, E);
        }
        GSYNC;
        {
            WSD;
            pg8::Gemm g{ACT0, WD2, NP_ROWS, DM, DFF}; pg8::StaticOrder S; S.init(NP_ROWS, DM, G, bx);
            pg8::EpiRes<1, 1> E{nullptr, nullptr, HB, P.out, 0.5f, SS3, h * NP_ROWS};
            pg8::gemm_phase<pg8::EpiRes<1, 1>, pg8::StaticOrder, true, true>(lds, g, S, E);
        }
        GSYNC;
    }
    {
        IDS;
        const float* fw = P.in[22];
        for (int r = gw; r < NTOK; r += NGW) {
            const float rstd = __builtin_amdgcn_rsqf(SS3[r] * (1.f / DM) + EPS); float* o = P.out + (size_t)r * DM;
#pragma unroll
            for (int j = 0; j < 4; ++j) { const int c = 4 * lane + 256 * j; f32x4 v = *(const f32x4*)(o + c); const f32x4 w = *(const f32x4*)(fw + c);
                v[0] *= rstd * w[0]; v[1] *= rstd * w[1]; v[2] *= rstd * w[2]; v[3] *= rstd * w[3]; *(f32x4*)(o + c) = v; }
        }
    }
}

extern "C" void kernel_launch(void* const* d_in, const int* in_sizes, int n_in, void* d_out, int out_size, void* d_ws, size_t ws_size, hipStream_t stream) {
    static int grid = 0;
    if (grid == 0) {
        if (n_in != 23 || out_size != NTOK * DM || ws_size < WS_END) { fprintf(stderr, "kernel_launch: unexpected shapes (n_in %d out %d ws %zu)\n", n_in, out_size, ws_size); grid = -1; return; }
        int dev = 0, cus = 0, per_cu = 0;
        hipGetDevice(&dev); hipDeviceGetAttribute(&cus, hipDeviceAttributeMultiprocessorCount, dev);
        hipFuncSetAttribute((const void*)fwd_mega, hipFuncAttributeMaxDynamicSharedMemorySize, LDS_BYTES);
        hipOccupancyMaxActiveBlocksPerMultiprocessor(&per_cu, (const void*)fwd_mega, 512, LDS_BYTES);
        if (per_cu < 1) { fprintf(stderr, "kernel_launch: occupancy query says %d blocks per CU\n", per_cu); grid = -1; return; }
        grid = cus;
    }
    if (grid < 0) return;
    Params p{};
    for (int i = 0; i < 23; ++i) p.in[i] = (const float*)d_in[i];
    p.out = (float*)d_out; p.ws = (unsigned char*)d_ws;
    (void)hipMemsetAsync((unsigned char*)d_ws + WS_BAR, 0, 16384, stream);
    void* args[] = {&p};
    hipError_t e = hipLaunchCooperativeKernel((const void*)fwd_mega, dim3(grid), dim3(512), args, LDS_BYTES, stream);
    if (e != hipSuccess) fprintf(stderr, "cooperative launch failed: %s (grid %d)\n", hipGetErrorString(e), grid);
}
```

```cpp
#include <hip/hip_runtime.h>
#include <hip/hip_cooperative_groups.h>
#include <cstdio>
#include <cstdint>
namespace cg = cooperative_groups;

#ifndef STAGE
#define STAGE 99
#endif

#define LAS __attribute__((address_space(3)))
typedef unsigned short bf16_t;
typedef short bf16x8 __attribute__((ext_vector_type(8)));
typedef float f32x4 __attribute__((ext_vector_type(4)));
typedef unsigned u32x4 __attribute__((ext_vector_type(4)));

constexpr int DM = 1024, DFF = 2816, NTOK = 32768, NP_ROWS = 16384;
constexpr int GROUP_ROWS = 8192, NGROUPS = 4;
constexpr float EPS = 1e-6f;
constexpr int IN_COLS = 10272;
constexpr int NPRE = 6144, NPOST = 4096;

constexpr size_t MiB = 1u << 20;
constexpr size_t WS_SS0 = 0, WS_SS1 = 128 * 1024, WS_SS2 = 256 * 1024, WS_SS3 = 384 * 1024, WS_SSM0 = 512 * 1024, WS_SSM1 = 512 * 1024 + 256, WS_LBV = 520 * 1024;
constexpr size_t WS_BAR = 640 * 1024;
constexpr size_t WS_META = 1 * MiB;
constexpr size_t M_HBM = WS_META, M_ACTM = WS_META + 32 * 1024, M_XBCM = WS_META + 128 * 1024, M_QM = WS_META + 192 * 1024, M_LOGFM = WS_META + 224 * 1024,
                 M_VM = WS_META + 288 * 1024, M_DTM = WS_META + 320 * 1024, M_XCM = WS_META + 324 * 1024;
constexpr size_t WS_DT = 3 * MiB;
constexpr size_t WS_WGU1 = 7 * MiB, WS_WD1 = 18 * MiB, WS_WGU2 = 23 * MiB + 512 * 1024, WS_WD2 = 34 * MiB + 512 * 1024, WS_WPRE = 40 * MiB, WS_WPOST = 52 * MiB,
                 WS_WA = 60 * MiB, WS_WB = 62 * MiB, WS_WOUT = 64 * MiB, WS_WDT = 66 * MiB;
constexpr size_t WS_HB = 67 * MiB;
constexpr size_t WS_F = 131 * MiB;
constexpr size_t WS_QB = WS_F, WS_VB = WS_F + 16 * MiB, WS_ZG = WS_F + 32 * MiB, WS_GATES = WS_F + 64 * MiB;
constexpr size_t WS_QE1 = 227 * MiB, WS_HSC = 243 * MiB;
constexpr size_t WS_END = 256 * MiB;
constexpr size_t DO_Y = 0, DO_XC = 32 * MiB, DO_LOGF = 64 * MiB, DO_OF = 96 * MiB, DO_OB = 112 * MiB;

__device__ __forceinline__ unsigned f2bf(float f) { unsigned u = __builtin_bit_cast(unsigned, f); return (u + 0x7fffu + ((u >> 16) & 1u)) >> 16; }
typedef float f32x2_t __attribute__((ext_vector_type(2)));
typedef __bf16 bf16x2_t __attribute__((ext_vector_type(2)));
__device__ __forceinline__ unsigned pk2(float lo, float hi) { const f32x2_t v = {lo, hi}; const bf16x2_t b = __builtin_convertvector(v, bf16x2_t); return __builtin_bit_cast(unsigned, b); }
__device__ __forceinline__ float bflo(unsigned w) { return __builtin_bit_cast(float, w << 16); }
__device__ __forceinline__ float bfhi(unsigned w) { return __builtin_bit_cast(float, w & 0xffff0000u); }
__device__ __forceinline__ float bf2f(bf16_t h) { return __builtin_bit_cast(float, ((unsigned)h) << 16); }
__device__ __forceinline__ float frcp(float x) { return __builtin_amdgcn_rcpf(x); }
__device__ __forceinline__ float fsigmoid(float x) { return frcp(1.f + __expf(-x)); }
__device__ __forceinline__ float fsilu(float x) { return x * frcp(1.f + __expf(-x)); }
__device__ __forceinline__ unsigned pkh2(float lo, float hi) { _Float16 a = (_Float16)lo, b = (_Float16)hi; return (unsigned)__builtin_bit_cast(unsigned short, a) | ((unsigned)__builtin_bit_cast(unsigned short, b) << 16); }
__device__ __forceinline__ float hlo(unsigned w) { return (float)__builtin_bit_cast(_Float16, (unsigned short)(w & 0xffffu)); }
__device__ __forceinline__ float hhi(unsigned w) { return (float)__builtin_bit_cast(_Float16, (unsigned short)(w >> 16)); }
__device__ __forceinline__ int fresh_tid() { int t = threadIdx.x; asm volatile("" : "+v"(t)); return t; }
__device__ __forceinline__ float wave_sum(float v) {
#pragma unroll
    for (int o = 1; o < 64; o <<= 1) v += __shfl_xor(v, o);
    return v;
}
template <int CTRL, int RM> __device__ __forceinline__ float dppmov(float v) { return __builtin_bit_cast(float, __builtin_amdgcn_update_dpp(0, __builtin_bit_cast(int, v), CTRL, RM, 0xf, false)); }
__device__ __forceinline__ float wave_scan(float v, int) {
    v += dppmov<0x111, 0xf>(v); v += dppmov<0x112, 0xf>(v); v += dppmov<0x114, 0xf>(v); v += dppmov<0x118, 0xf>(v);
    v += dppmov<0x142, 0xa>(v); v += dppmov<0x143, 0xc>(v);
    return v;
}
__device__ __forceinline__ float lane_bcast(float v, int l) { return __builtin_bit_cast(float, __builtin_amdgcn_readlane(__builtin_bit_cast(int, v), l)); }
__device__ __forceinline__ void unpack8(const u32x4 w, float (&f)[8]) {
    f[0] = bflo(w.x); f[1] = bfhi(w.x); f[2] = bflo(w.y); f[3] = bfhi(w.y); f[4] = bflo(w.z); f[5] = bfhi(w.z); f[6] = bflo(w.w); f[7] = bfhi(w.w);
}
__device__ __forceinline__ u32x4 pack8(const float (&f)[8]) { u32x4 w; w.x = pk2(f[0], f[1]); w.y = pk2(f[2], f[3]); w.z = pk2(f[4], f[5]); w.w = pk2(f[6], f[7]); return w; }

namespace pg8 {
#define PG8_LAS __attribute__((address_space(3)))
constexpr int BM = 256, BK = 64, HALF = 128, HTB = HALF * BK * 2, STAGE_BYTES = 8 * HTB, NXCD = 8, WGM = 8;
__host__ __device__ __forceinline__ int lds_byte(int r, int c) { const int st = (r >> 4) * 2 + (c >> 5), rr = r & 15, cc = c & 31, ob = rr * 64 + cc * 2; return st * 1024 + (ob ^ (((ob >> 9) & 1) << 5)); }
__host__ __device__ __forceinline__ void stage_rc(int b, int& R, int& C) { const int st = b / 1024, sb = b % 1024, swz = sb ^ (((sb >> 9) & 1) << 5); R = (st >> 1) * 16 + swz / 64; C = (st & 1) * 32 + (swz % 64) / 2; }
__host__ __device__ __forceinline__ int perm32(int rho) { const int n = rho >> 4, i = rho & 15; return 8 * (i >> 2) + 4 * n + (i & 3); }
struct Unit { int pm, pn; };
struct Gemm { const bf16_t* A; const bf16_t* Bt; int M, N, K; };
struct StaticOrder {
    int nM, nN, nwg, G, c;
    __device__ void init(int M, int N, int G_, int c_) { nM = M / BM; nN = N / BM; nwg = nM * nN; G = G_; c = c_; }
    __device__ bool next(int i, Unit& u) const {
        if (c < 0) return false;
        const long L = (long)i * G + c; if (L >= nwg) return false;
        int wgid = (int)L; { const int q = nwg / NXCD, r = nwg % NXCD, xcd = wgid % NXCD, off = wgid / NXCD; wgid = (xcd < r ? xcd * (q + 1) : r * (q + 1) + (xcd - r) * q) + off; }
        const int nig = WGM * nN, gid = wgid / nig, fm = gid * WGM, gsz = (nM - fm) < WGM ? (nM - fm) : WGM;
        u.pm = fm + ((wgid % nig) % gsz); u.pn = (wgid % nig) / gsz; return true;
    }
    __device__ __forceinline__ void a_ready(const Unit&) const {}
    __device__ __forceinline__ void done(const Unit&) const {}
};

template <class Epi, class Sched, bool ALIGN_EPI = false, bool SP2 = false>
__device__ __forceinline__ void gemm_phase(PG8_LAS unsigned char* lds, const Gemm g, const Sched& S, const Epi& E) {
    const int tid = fresh_tid(), wid = __builtin_amdgcn_readfirstlane(tid >> 6), lane = tid & 63, wr = wid >> 2, wc = wid & 3, fr = lane & 15, fq = lane >> 4;
    const int K = g.K, nt = K / BK;
    unsigned voffA[2], voffB[2];
#pragma unroll
    for (int i = 0; i < 2; ++i) { int R, C; stage_rc(tid * 16 + i * 8192, R, C); const int Rb = Epi::PERM ? ((R & ~31) + perm32(R & 31)) : R;
        voffA[i] = (unsigned)(R * K + C) * 2u; voffB[i] = (unsigned)(Rb * K + C) * 2u; }
    const size_t kstep = (size_t)(BK * 2);
    const size_t hstep = (size_t)HALF * K * 2;
    const size_t tstep = 2 * hstep;
    const unsigned ldsw = (unsigned)wid * 1024u;
    const int aoff = lds_byte(wr * 64 + fr, fq * 8), boff = lds_byte(wc * 32 + fr, fq * 8);
#define PG8_SA(b, h) (((b) * 2 + (h)) * HTB)
#define PG8_SB(b, h) ((4 + (b) * 2 + (h)) * HTB)
#define PG8_STAGE(bufoff, gbase, voff) do { _Pragma("unroll") for (int _i = 0; _i < 2; ++_i) \
        __builtin_amdgcn_global_load_lds((const unsigned*)((const char*)(gbase) + (voff)[_i]), (PG8_LAS unsigned*)(lds + (bufoff) + ldsw + _i * 8192), 16, 0, 0); } while (0)
#define PG8_LDA(dst, b, h) do { _Pragma("unroll") for (int m = 0; m < 4; ++m) _Pragma("unroll") for (int k = 0; k < 2; ++k) dst[m][k] = *(const PG8_LAS bf16x8*)(lds + PG8_SA(b, h) + aoff + m * 2048 + k * 1024); } while (0)
#define PG8_LDB(dst, b, h) do { _Pragma("unroll") for (int n = 0; n < 2; ++n) _Pragma("unroll") for (int k = 0; k < 2; ++k) dst[n][k] = *(const PG8_LAS bf16x8*)(lds + PG8_SB(b, h) + boff + n * 2048 + k * 1024); } while (0)
#define PG8_MMA(ai, bj, At, Bt) do { __builtin_amdgcn_s_setprio(1); _Pragma("unroll") for (int m = 0; m < 4; ++m) _Pragma("unroll") for (int n = 0; n < 2; ++n) _Pragma("unroll") for (int k = 0; k < 2; ++k) \
        acc[ai][bj][m][n] = __builtin_amdgcn_mfma_f32_16x16x32_bf16(Bt[n][k], At[m][k], acc[ai][bj][m][n], 0, 0, 0); __builtin_amdgcn_s_setprio(0); } while (0)
#define PG8_WAIT_V(n) asm volatile("s_waitcnt vmcnt(" #n ")" ::: "memory")
#define PG8_WAIT_L(n) asm volatile("s_waitcnt lgkmcnt(" #n ")" ::: "memory")
#define PG8_BAR __builtin_amdgcn_s_barrier()
#define PG8_SCHED __builtin_amdgcn_sched_barrier(0)
    Unit cur, nxt; int ui = 0;
    if (!S.next(0, cur)) return;
    f32x4 acc[2][2][4][2];
#pragma unroll
    for (int a = 0; a < 2; ++a)
#pragma unroll
        for (int b = 0; b < 2; ++b)
#pragma unroll
            for (int m = 0; m < 4; ++m)
#pragma unroll
                for (int n = 0; n < 2; ++n) acc[a][b][m][n] = (f32x4){0.f, 0.f, 0.f, 0.f};
    bf16x8 At[4][2], B0[2][2], B1[2][2];
    const char* cA = (const char*)g.A + (size_t)cur.pm * tstep; const char* cB = (const char*)g.Bt + (size_t)cur.pn * tstep;
    S.a_ready(cur);
    if constexpr (SP2) {
        PG8_STAGE(PG8_SB(0, 0), cB, voffB); PG8_STAGE(PG8_SB(0, 1), cB + hstep, voffB); PG8_STAGE(PG8_SA(0, 0), cA, voffA); PG8_STAGE(PG8_SA(0, 1), cA + hstep, voffA);
        if (wr == 1) PG8_BAR;
        PG8_WAIT_V(2); PG8_BAR;
        PG8_STAGE(PG8_SB(1, 0), cB + kstep, voffB); PG8_STAGE(PG8_SA(1, 0), cA + kstep, voffA); PG8_STAGE(PG8_SB(1, 1), cB + hstep + kstep, voffB);
        PG8_WAIT_V(6); PG8_BAR;
    } else {
        PG8_STAGE(PG8_SB(0, 0), cB, voffB); PG8_STAGE(PG8_SA(0, 0), cA, voffA); PG8_STAGE(PG8_SB(0, 1), cB + hstep, voffB); PG8_STAGE(PG8_SA(0, 1), cA + hstep, voffA);
        if (wr == 1) PG8_BAR;
        PG8_WAIT_V(4); PG8_BAR;
        PG8_STAGE(PG8_SB(1, 0), cB + kstep, voffB); PG8_STAGE(PG8_SA(1, 0), cA + kstep, voffA); PG8_STAGE(PG8_SB(1, 1), cB + hstep + kstep, voffB);
        PG8_WAIT_V(6); PG8_BAR;
    }
    for (;;) {
        const bool has_next = S.next(ui + 1, nxt);
        const char* nA = has_next ? (const char*)g.A + (size_t)nxt.pm * tstep : cA; const char* nB = has_next ? (const char*)g.Bt + (size_t)nxt.pn * tstep : cB;
        for (int t = 0; t < nt; t += 2) {
            const bool last = (t == nt - 2);
            const char* a1 = cA + (size_t)(t + 1) * kstep;
            const char* a2 = last ? nA : cA + (size_t)(t + 2) * kstep; const char* b2 = last ? nB : cB + (size_t)(t + 2) * kstep;
            const char* a3 = a2 + kstep; const char* b3 = b2 + kstep;
            if (last && has_next) S.a_ready(nxt);
            if constexpr (SP2) {
            PG8_LDB(B0, 0, 0); PG8_LDB(B1, 0, 1); PG8_SCHED; PG8_LDA(At, 0, 0); PG8_STAGE(PG8_SA(1, 1), a1 + hstep, voffA);
            PG8_WAIT_V(8); PG8_WAIT_L(0); PG8_BAR; PG8_MMA(0, 0, At, B0); PG8_MMA(0, 1, At, B1); PG8_BAR; PG8_SCHED;
            PG8_LDA(At, 0, 1); PG8_STAGE(PG8_SB(0, 0), b2, voffB); PG8_STAGE(PG8_SB(0, 1), b2 + hstep, voffB); PG8_STAGE(PG8_SA(0, 0), a2, voffA);
            PG8_WAIT_V(8); PG8_WAIT_L(0); PG8_BAR; PG8_MMA(1, 0, At, B0); PG8_MMA(1, 1, At, B1); PG8_BAR; PG8_SCHED;
            PG8_LDB(B0, 1, 0); PG8_LDB(B1, 1, 1); PG8_SCHED; PG8_LDA(At, 1, 0); PG8_STAGE(PG8_SA(0, 1), a2 + hstep, voffA);
            PG8_WAIT_V(8); PG8_WAIT_L(0); PG8_BAR; PG8_MMA(0, 0, At, B0); PG8_MMA(0, 1, At, B1); PG8_BAR; PG8_SCHED;
            PG8_LDA(At, 1, 1); PG8_STAGE(PG8_SB(1, 0), b3, voffB); PG8_STAGE(PG8_SB(1, 1), b3 + hstep, voffB); PG8_STAGE(PG8_SA(1, 0), a3, voffA);
            PG8_WAIT_V(8); PG8_WAIT_L(0); PG8_BAR; PG8_MMA(1, 0, At, B0); PG8_MMA(1, 1, At, B1); PG8_BAR; PG8_SCHED;
            } else {
            PG8_LDB(B0, 0, 0); PG8_SCHED; PG8_LDA(At, 0, 0); PG8_STAGE(PG8_SA(1, 1), a1 + hstep, voffA);
            PG8_WAIT_L(8); PG8_BAR; PG8_WAIT_L(0); PG8_MMA(0, 0, At, B0); PG8_BAR; PG8_SCHED;
            PG8_LDB(B1, 0, 1); PG8_STAGE(PG8_SB(0, 0), b2, voffB);
            PG8_BAR; PG8_WAIT_L(0); PG8_MMA(0, 1, At, B1); PG8_BAR;
            PG8_LDA(At, 0, 1); PG8_STAGE(PG8_SA(0, 0), a2, voffA);
            PG8_BAR; PG8_WAIT_L(0); PG8_MMA(1, 0, At, B0); PG8_BAR; PG8_SCHED;
            PG8_STAGE(PG8_SB(0, 1), b2 + hstep, voffB);
            PG8_WAIT_V(6); PG8_BAR; PG8_MMA(1, 1, At, B1); PG8_BAR;
            PG8_LDB(B0, 1, 0); PG8_SCHED; PG8_LDA(At, 1, 0); PG8_STAGE(PG8_SA(0, 1), a2 + hstep, voffA);
            PG8_WAIT_L(8); PG8_BAR; PG8_WAIT_L(0); PG8_MMA(0, 0, At, B0); PG8_BAR; PG8_SCHED;
            PG8_LDB(B1, 1, 1); PG8_STAGE(PG8_SB(1, 0), b3, voffB);
            PG8_BAR; PG8_WAIT_L(0); PG8_MMA(0, 1, At, B1); PG8_BAR;
            PG8_LDA(At, 1, 1); PG8_STAGE(PG8_SA(1, 0), a3, voffA);
            PG8_BAR; PG8_WAIT_L(0); PG8_MMA(1, 0, At, B0); PG8_BAR; PG8_SCHED;
            PG8_STAGE(PG8_SB(1, 1), b3 + hstep, voffB);
            PG8_WAIT_V(6); PG8_BAR; PG8_MMA(1, 1, At, B1); PG8_BAR;
            }
        }
        if constexpr (ALIGN_EPI) { if (wr == 0) PG8_BAR; }
        E(acc, cur, wr, wc, fr, fq); S.done(cur);
        if (!has_next) break;
#pragma unroll
        for (int a = 0; a < 2; ++a)
#pragma unroll
            for (int b = 0; b < 2; ++b)
#pragma unroll
                for (int m = 0; m < 4; ++m)
#pragma unroll
                    for (int n = 0; n < 2; ++n) acc[a][b][m][n] = (f32x4){0.f, 0.f, 0.f, 0.f};
        cur = nxt; cA = nA; cB = nB; ++ui;
        if constexpr (ALIGN_EPI) { if (wr == 1) PG8_BAR; }
    }
    PG8_WAIT_V(0);
    if constexpr (!ALIGN_EPI) { if (wr == 0) PG8_BAR; }
    PG8_BAR;
#undef PG8_SA
#undef PG8_SB
#undef PG8_STAGE
#undef PG8_LDA
#undef PG8_LDB
#undef PG8_MMA
#undef PG8_WAIT_V
#undef PG8_WAIT_L
#undef PG8_BAR
#undef PG8_SCHED
}

typedef f32x4 Acc[2][2][4][2];

struct EpiGU {
    static constexpr bool PERM = true;
    bf16_t* act0; bf16_t* act1; int split_row; const float* ss; int row_base;
    __device__ __forceinline__ void operator()(const Acc& acc, const Unit& u, int wr, int wc, int fr, int fq) const {
        const int row0 = row_base + u.pm * BM + wr * 64 + fr, col = u.pn * 128 + wc * 32 + 8 * fq;
#pragma unroll
        for (int ai = 0; ai < 2; ++ai)
#pragma unroll
            for (int m = 0; m < 4; ++m) {
                const int r = row0 + ai * HALF + m * 16;
                const float s = __builtin_amdgcn_rsqf(ss[r] * (1.f / DM) + EPS);
                bf16_t* dst = (r < split_row ? act0 + (size_t)r * DFF : act1 + (size_t)(r - split_row) * DFF) + col;
                float o[8];
#pragma unroll
                for (int n = 0; n < 2; ++n)
#pragma unroll
                    for (int i = 0; i < 4; ++i) { const float g = acc[ai][0][m][n][i] * s, up = acc[ai][1][m][n][i] * s; o[4 * n + i] = fsilu(g) * up; }
                *(u32x4*)dst = pack8(o);
            }
    }
};

template <int RES  , int OUT  >
struct EpiRes {
    static constexpr bool PERM = true;
    const float* xp; const float* xs; bf16_t* hb; float* outf; float alpha; float* ss_out; int row_base;
    __device__ __forceinline__ void operator()(const Acc& acc, const Unit& u, int wr, int wc, int fr, int fq) const {
        const int row0 = row_base + u.pm * BM + wr * 64 + fr, col0 = u.pn * BM + wc * 32 + 8 * fq;
#pragma unroll
        for (int ai = 0; ai < 2; ++ai)
#pragma unroll
            for (int m = 0; m < 4; ++m) {
                const int r = row0 + ai * HALF + m * 16; float sq = 0.f;
#pragma unroll
                for (int bj = 0; bj < 2; ++bj) {
                    const int c = col0 + bj * HALF; float res[8], v[8];
                    if (RES == 0) { const float* xr = (r < NP_ROWS ? xp + (size_t)r * DM : xs + (size_t)(r - NP_ROWS) * DM) + c; const f32x4 a = *(const f32x4*)xr, b = *(const f32x4*)(xr + 4);
                        res[0] = a[0]; res[1] = a[1]; res[2] = a[2]; res[3] = a[3]; res[4] = b[0]; res[5] = b[1]; res[6] = b[2]; res[7] = b[3]; }
                    else { const u32x4 w = *(const u32x4*)(hb + (size_t)r * DM + c); unpack8(w, res); }
#pragma unroll
                    for (int n = 0; n < 2; ++n)
#pragma unroll
                        for (int i = 0; i < 4; ++i) { const float t = res[4 * n + i] + alpha * acc[ai][bj][m][n][i]; v[4 * n + i] = t; sq += t * t; }
                    if (OUT == 0) *(u32x4*)(hb + (size_t)r * DM + c) = pack8(v);
                    else { float* o = outf + (size_t)r * DM + c; *(f32x4*)o = (f32x4){v[0], v[1], v[2], v[3]}; *(f32x4*)(o + 4) = (f32x4){v[4], v[5], v[6], v[7]}; }
                }
                sq += __shfl_xor(sq, 16); sq += __shfl_xor(sq, 32);
                if (fq == 0) atomicAdd(ss_out + r, sq);
            }
    }
};

struct EpiPre {
    static constexpr bool PERM = true;
    bf16_t* xbc; bf16_t* q; bf16_t* logf; bf16_t* v; const float* ss; const float* lbv; int grow0;
    __device__ __forceinline__ void operator()(const Acc& acc, const Unit& u, int wr, int wc, int fr, int fq) const {
        const int row0 = u.pm * BM + wr * 64 + fr, pn = u.pn;
        int mode, ld, cb; bf16_t* base;
        if (pn < 8) { mode = 0; base = xbc; ld = 2048; cb = pn * 256; }
        else if (pn < 12) { mode = 1; base = q; ld = 1024; cb = (pn - 8) * 256; }
        else if (pn < 20) { mode = 2; base = logf; ld = 2048; cb = (pn - 12) * 256; }
        else { mode = 0; base = v; ld = 1024; cb = (pn - 20) * 256; }
        const int col0 = cb + wc * 32 + 8 * fq;
#pragma unroll
        for (int ai = 0; ai < 2; ++ai)
#pragma unroll
            for (int m = 0; m < 4; ++m) {
                const int r = row0 + ai * HALF + m * 16;
                const float s = __builtin_amdgcn_rsqf(ss[grow0 + r] * (1.f / DM) + EPS);
#pragma unroll
                for (int bj = 0; bj < 2; ++bj) {
                    const int c = col0 + bj * HALF; float o[8];
#pragma unroll
                    for (int n = 0; n < 2; ++n)
#pragma unroll
                        for (int i = 0; i < 4; ++i) o[4 * n + i] = acc[ai][bj][m][n][i] * s;
                    u32x4 w;
                    if (mode == 0) w = pack8(o);
                    else if (mode == 1) {
#pragma unroll
                        for (int i = 0; i < 8; ++i) o[i] = fsilu(o[i]);
                        w = pack8(o);
                    } else {
                        const f32x4 l0 = *(const f32x4*)(lbv + c), l1 = *(const f32x4*)(lbv + c + 4);
                        const float lb[8] = {l0[0], l0[1], l0[2], l0[3], l1[0], l1[1], l1[2], l1[3]};
#pragma unroll
                        for (int i = 0; i < 8; ++i) { const float f = lb[i] + (1.f - lb[i]) * fsigmoid(o[i]); o[i] = __logf(f); }
                        w.x = pkh2(o[0], o[1]); w.y = pkh2(o[2], o[3]); w.z = pkh2(o[4], o[5]); w.w = pkh2(o[6], o[7]);
                    }
                    *(u32x4*)(base + (size_t)r * ld + c) = w;
                }
            }
    }
};

struct EpiPost {
    static constexpr bool PERM = true;
    bf16_t* out; const float* ss; int grow0; int gmode;
    __device__ __forceinline__ void operator()(const Acc& acc, const Unit& u, int wr, int wc, int fr, int fq) const {
        const int row0 = u.pm * BM + wr * 64 + fr, col0 = u.pn * 256 + wc * 32 + 8 * fq;
#pragma unroll
        for (int ai = 0; ai < 2; ++ai)
#pragma unroll
            for (int m = 0; m < 4; ++m) {
                const int r = row0 + ai * HALF + m * 16;
                const float s = __builtin_amdgcn_rsqf(ss[grow0 + r] * (1.f / DM) + EPS);
#pragma unroll
                for (int bj = 0; bj < 2; ++bj) {
                    const int c = col0 + bj * HALF; float o[8];
#pragma unroll
                    for (int n = 0; n < 2; ++n)
#pragma unroll
                        for (int i = 0; i < 4; ++i) { const float t = acc[ai][bj][m][n][i] * s; o[4 * n + i] = gmode ? fsigmoid(t) : fsilu(t); }
                    *(u32x4*)(out + (size_t)r * 2048 + c) = pack8(o);
                }
            }
    }
};

template <int FIRST>
struct EpiMerge {
    static constexpr bool PERM = true;
    bf16_t* merged; const bf16_t* gates; int rbase;
    __device__ __forceinline__ void operator()(const Acc& acc, const Unit& u, int wr, int wc, int fr, int fq) const {
        const int row0 = rbase + u.pm * BM + wr * 64 + fr, col0 = u.pn * BM + wc * 32 + 8 * fq;
#pragma unroll
        for (int ai = 0; ai < 2; ++ai)
#pragma unroll
            for (int m = 0; m < 4; ++m) {
                const int r = row0 + ai * HALF + m * 16;
#pragma unroll
                for (int bj = 0; bj < 2; ++bj) {
                    const int c = col0 + bj * HALF; float gt[8], o[8];
                    unpack8(*(const u32x4*)(gates + (size_t)r * 2048 + (FIRST ? 0 : 1024) + c), gt);
                    if (FIRST) {
#pragma unroll
                        for (int i = 0; i < 8; ++i) o[i] = 0.f;
                    } else unpack8(*(const u32x4*)(merged + (size_t)r * DM + c), o);
#pragma unroll
                    for (int n = 0; n < 2; ++n)
#pragma unroll
                        for (int i = 0; i < 4; ++i) o[4 * n + i] += gt[4 * n + i] * acc[ai][bj][m][n][i];
                    *(u32x4*)(merged + (size_t)r * DM + c) = pack8(o);
                }
            }
    }
};
}

__device__ __forceinline__ f32x4 sg16(const bf16_t* A, int lda, const bf16_t* Bt, int K, int lane) {
    const int r = lane & 15, q = lane >> 4;
    const bf16_t* ap = A + (size_t)r * lda + q * 8; const bf16_t* bp = Bt + (size_t)r * K + q * 8;
    f32x4 acc = {0.f, 0.f, 0.f, 0.f};
    for (int k = 0; k < K; k += 256) {
        bf16x8 a[8], b[8];
#pragma unroll
        for (int u = 0; u < 8; ++u) { a[u] = *(const bf16x8*)(ap + k + 32 * u); b[u] = *(const bf16x8*)(bp + k + 32 * u); }
#pragma unroll
        for (int u = 0; u < 8; ++u) acc = __builtin_amdgcn_mfma_f32_16x16x32_bf16(a[u], b[u], acc, 0, 0, 0);
    }
    return acc;
}

__device__ __forceinline__ void tr_item(const float* W, int N, int K, int n0, int k0, bf16_t* WT, int drow, const float* scale, LAS float* scr, int lane) {
#pragma unroll 8
    for (int i = 0; i < 32; ++i) { const int kk = 2 * i + (lane >> 5); float v = W[(size_t)(k0 + kk) * N + n0 + (lane & 31)]; if (scale) v *= scale[k0 + kk]; scr[kk * 33 + (lane & 31)] = v; }
    asm volatile("s_waitcnt lgkmcnt(0)" ::: "memory");
    const int c = lane & 7;
#pragma unroll
    for (int j = 0; j < 4; ++j) { const int n = (lane >> 3) + 8 * j; const LAS float* s = scr + (8 * c) * 33 + n;
        u32x4 o; o.x = pk2(s[0 * 33], s[1 * 33]); o.y = pk2(s[2 * 33], s[3 * 33]); o.z = pk2(s[4 * 33], s[5 * 33]); o.w = pk2(s[6 * 33], s[7 * 33]);
        *(u32x4*)(WT + (size_t)(drow + n) * K + k0 + 8 * c) = o; }
    asm volatile("s_waitcnt lgkmcnt(0)" ::: "memory");
}
__device__ __forceinline__ void tr_job(const float* W, int N, int K, int c0, int nc, bf16_t* WT, int d0, int mode, const float* scale, LAS float* scr, int gw, int ngw, int lane) {
    const int nblk = nc / 32, nitems = (K / 64) * nblk;
    for (int it = gw; it < nitems; it += ngw) {
        const int kb = it / nblk, nb = it % nblk, n0 = 32 * nb; int drow;
        if (mode == 0) drow = d0 + n0;
        else { const int j = n0 < DFF ? n0 : n0 - DFF; drow = (j / 128) * 256 + (j % 128) + (n0 < DFF ? 0 : 128); }
        tr_item(W, N, K, c0 + n0, 64 * kb, WT, drow, scale, scr, lane);
    }
}

constexpr int B_X1 = 0, B_X2 = 17408, B_VA = 35840, B_VB = 46080, B_ACS = 56320, B_R = 56576, B_C1 = 56832, B_C2 = 57344, B_E = 57856, BUFSZ = 58368;
constexpr int L_M = 2 * BUFSZ, L_S = L_M + 9216, L_OUT = L_S + 17408, SCAN_LDS_END = L_OUT + 9216;
constexpr int P136 = 136, P144 = 144, P80 = 80, P72 = 72;
typedef short v4i16_t __attribute__((ext_vector_type(4)));

#define LDF(base, row, col, pitch) (*(const LAS bf16x8*)(lds + (base) + ((row) * (pitch) + (col)) * 2))
__device__ __forceinline__ bf16x8 trfrag(LAS unsigned char* lds, int base, int pitch, int c, int ks, int lane) {
    const int g = lane >> 4, q = (lane & 15) >> 2, p = lane & 3;
    const int off = base + ((32 * ks + 8 * g + q) * pitch + 16 * c + 4 * p) * 2;
    const v4i16_t v0 = __builtin_amdgcn_ds_read_tr16_b64_v4i16((LAS v4i16_t*)(lds + off));
    const v4i16_t v1 = __builtin_amdgcn_ds_read_tr16_b64_v4i16((LAS v4i16_t*)(lds + off + 8 * pitch));
    return __builtin_shufflevector(v0, v1, 0, 1, 2, 3, 4, 5, 6, 7);
}

struct ScanItem {
    int kind;
    int head, dir, vh, nC;
    int row0;
    int grow0;
    const bf16_t* xc; const bf16_t* xcm; const float* dt; const float* dtm; float Aneg;
    const bf16_t* q; const bf16_t* logf; const bf16_t* v; const bf16_t* logfm; const bf16_t* vm; const float* hsc;
    bf16_t* out;
    int ocol;
};

template <int KIND>
__device__ __forceinline__ void scan_run(LAS unsigned char* lds, const ScanItem& it) {
    const int tid = fresh_tid(), lane = tid & 63, wv = __builtin_amdgcn_readfirstlane(tid >> 6), fr = lane & 15, fq = lane >> 4;
    const int nSteps = it.nC + (it.dir == 0 ? 1 : 0);
    const int tr = wv >> 1, tc0 = (wv & 1) * 2, nt0 = (wv & 1) * 4;
    const int r0 = tid >> 4, ch = tid & 15, rxr = tid >> 3, xch = tid & 7;
    f32x4 S[4];
#pragma unroll
    for (int i = 0; i < 4; ++i) S[i] = (f32x4){0.f, 0.f, 0.f, 0.f};
    u32x4 ra[2], rb[2], rx; float dtv = 0.f, sc1 = 0.f, sc2 = 0.f, sce = 0.f;
    const u32x4 Z4 = {0u, 0u, 0u, 0u};

#define SCAN_LOAD(st) do { \
        const bool meta = (it.dir == 0 && (st) == 0); \
        const int c = it.dir == 0 ? (st) - 1 : it.nC - 1 - (st); \
        if (meta) { \
            if (KIND == 0) { const int cb = (it.head >> 2) * 128 + 8 * ch; \
                ra[0] = Z4; rb[0] = Z4; rx = Z4; ra[1] = Z4; rb[1] = Z4; dtv = 0.f; \
                if (r0 < 16) { ra[0] = *(const u32x4*)(it.xcm + (size_t)r0 * 2048 + 1536 + cb); rb[0] = *(const u32x4*)(it.xcm + (size_t)r0 * 2048 + 1024 + cb); } \
                if (rxr < 16) rx = *(const u32x4*)(it.xcm + (size_t)rxr * 2048 + it.head * 64 + 8 * xch); \
                if (lane < 16) dtv = it.dtm[lane * 32 + it.head]; } \
            else { ra[0] = Z4; ra[1] = Z4; rb[0] = Z4; rb[1] = Z4; rx = Z4; \
                if (lane < 16) { rb[0] = *(const u32x4*)(it.logfm + (size_t)lane * 2048 + it.head * 128 + 8 * wv); rb[1] = *(const u32x4*)(it.logfm + (size_t)lane * 2048 + it.head * 128 + 8 * (wv + 8)); \
                    rx = *(const u32x4*)(it.vm + (size_t)lane * 1024 + it.head * 128 + it.vh * 64 + 8 * wv); } } \
        } else { \
            const size_t g0 = (size_t)(it.row0 + 64 * c + (it.dir == 0 ? r0 : 63 - r0)), g1 = (size_t)(it.row0 + 64 * c + (it.dir == 0 ? r0 + 32 : 31 - r0)), gx = (size_t)(it.row0 + 64 * c + (it.dir == 0 ? rxr : 63 - rxr)); \
            if (KIND == 0) { const int cb = (it.head >> 2) * 128 + 8 * ch; \
                ra[0] = *(const u32x4*)(it.xc + g0 * 2048 + 1536 + cb); ra[1] = *(const u32x4*)(it.xc + g1 * 2048 + 1536 + cb); \
                rb[0] = *(const u32x4*)(it.xc + g0 * 2048 + 1024 + cb); rb[1] = *(const u32x4*)(it.xc + g1 * 2048 + 1024 + cb); \
                rx = *(const u32x4*)(it.xc + gx * 2048 + it.head * 64 + 8 * xch); \
                dtv = it.dt[(size_t)(it.grow0 + 64 * c + (it.dir == 0 ? lane : 63 - lane)) * 32 + it.dir * 16 + it.head]; } \
            else { const int cq = it.head * 128 + 8 * ch; \
                ra[0] = *(const u32x4*)(it.q + g0 * 1024 + cq); ra[1] = *(const u32x4*)(it.q + g1 * 1024 + cq); \
                rb[0] = *(const u32x4*)(it.logf + g0 * 2048 + it.dir * 1024 + cq); rb[1] = *(const u32x4*)(it.logf + g1 * 2048 + it.dir * 1024 + cq); \
                rx = *(const u32x4*)(it.v + gx * 1024 + it.head * 128 + it.vh * 64 + 8 * xch); \
                if (tid < 128) { const float* hp = it.hsc + (size_t)(it.row0 / 64 + c) * 6144 + it.dir * 1024 + it.head * 128 + tid; sc1 = hp[0]; sc2 = hp[2048]; sce = hp[4096]; } } \
        } } while (0)

#define SCAN_PREP(bo) do { \
        if (KIND == 0) { \
            const float a_ = dtv * it.Aneg; const float acs = wave_scan(a_, lane); const float aend = lane_bcast(acs, 63); \
            *(LAS u32x4*)(lds + (bo) + B_X1 + (r0 * P136 + 8 * ch) * 2) = ra[0]; *(LAS u32x4*)(lds + (bo) + B_X1 + ((r0 + 32) * P136 + 8 * ch) * 2) = ra[1]; \
            *(LAS u32x4*)(lds + (bo) + B_X2 + (r0 * P144 + 8 * ch) * 2) = rb[0]; *(LAS u32x4*)(lds + (bo) + B_X2 + ((r0 + 32) * P144 + 8 * ch) * 2) = rb[1]; \
            const int srcl = 8 * wv + (lane >> 3); \
            const float dtr = __shfl(dtv, srcl), acr = __shfl(acs, srcl), dte = __expf(aend - acr); \
            float x_[8], xe_[8]; unpack8(rx, x_); \
            _Pragma("unroll") for (int e = 0; e < 8; ++e) { x_[e] *= dtr; xe_[e] = x_[e] * dte; } \
            *(LAS u32x4*)(lds + (bo) + B_VA + (rxr * P80 + 8 * xch) * 2) = pack8(x_); \
            *(LAS u32x4*)(lds + (bo) + B_VB + (rxr * P80 + 8 * xch) * 2) = pack8(xe_); \
            if (wv == 0) { *(LAS float*)(lds + (bo) + B_ACS + lane * 4) = acs; *(LAS float*)(lds + (bo) + B_R + lane * 4) = __expf(acs); } \
            if (wv == 1 || wv == 2) { const int n_ = (wv - 1) * 64 + lane; *(LAS float*)(lds + (bo) + B_C1 + n_ * 4) = __expf(aend); *(LAS float*)(lds + (bo) + B_C2 + n_ * 4) = 1.f; *(LAS float*)(lds + (bo) + B_E + n_ * 4) = 1.f; } \
        } else { \
            *(LAS u32x4*)(lds + (bo) + B_X1 + (r0 * P136 + 8 * ch) * 2) = ra[0]; *(LAS u32x4*)(lds + (bo) + B_X1 + ((r0 + 32) * P136 + 8 * ch) * 2) = ra[1]; \
            *(LAS u32x4*)(lds + (bo) + B_X2 + (r0 * P144 + 8 * ch) * 2) = rb[0]; *(LAS u32x4*)(lds + (bo) + B_X2 + ((r0 + 32) * P144 + 8 * ch) * 2) = rb[1]; \
            *(LAS u32x4*)(lds + (bo) + B_VA + (rxr * P80 + 8 * xch) * 2) = rx; \
            if (tid < 128) { *(LAS float*)(lds + (bo) + B_C1 + tid * 4) = sc1; *(LAS float*)(lds + (bo) + B_C2 + tid * 4) = sc2; *(LAS float*)(lds + (bo) + B_E + tid * 4) = sce; } \
        } } while (0)

    bool pend = false; int pc = 0;
#define SCAN_FLUSH() do { if (pend) { const int _r = tid >> 3, _sg = tid & 7; const u32x4 _v = *(const LAS u32x4*)(lds + L_OUT + (_r * P72 + 8 * _sg) * 2); \
        const int _lr = it.dir == 0 ? _r : 63 - _r; *(u32x4*)(it.out + (size_t)(it.row0 + 64 * pc + _lr) * 1024 + it.ocol + 8 * _sg) = _v; } } while (0)

    SCAN_LOAD(0);
    if (KIND == 1 && it.dir == 0) {
#pragma unroll
        for (int i = 0; i < 2; ++i) { const int cv = wv + 8 * i;
            float lf[8], ke[8];
            lf[0] = hlo(rb[i].x); lf[1] = hhi(rb[i].x); lf[2] = hlo(rb[i].y); lf[3] = hhi(rb[i].y); lf[4] = hlo(rb[i].z); lf[5] = hhi(rb[i].z); lf[6] = hlo(rb[i].w); lf[7] = hhi(rb[i].w);
#pragma unroll
            for (int e = 0; e < 8; ++e) {
                const float b = wave_scan(lf[e], lane); const float ref = lane_bcast(b, 31), tot = lane_bcast(b, 63);
                ke[e] = (1.f - __expf(lf[e])) * __expf(ref - b);
                if (lane == 0) { *(LAS float*)(lds + B_C1 + (8 * cv + e) * 4) = __expf(tot); *(LAS float*)(lds + B_C2 + (8 * cv + e) * 4) = __expf(tot - ref); *(LAS float*)(lds + B_E + (8 * cv + e) * 4) = __expf(ref); }
            }
            *(LAS u32x4*)(lds + B_X1 + (lane * P136 + 8 * cv) * 2) = Z4;
            *(LAS u32x4*)(lds + B_X2 + (lane * P144 + 8 * cv) * 2) = pack8(ke);
        }
        *(LAS u32x4*)(lds + B_VA + (lane * P80 + 8 * wv) * 2) = rx;
    } else SCAN_PREP(0);
    if (nSteps > 1) SCAN_LOAD(1);

    for (int st = 0; st < nSteps; ++st) {
        const int bo = (st & 1) * BUFSZ;
        const bool do_out = !(it.dir == 0 && st == 0);
        __syncthreads();
#pragma unroll
        for (int i = 0; i < 4; ++i) { const int n = 16 * (nt0 + i) + fr; const float e = *(const LAS float*)(lds + bo + B_E + n * 4);
#pragma unroll
            for (int j = 0; j < 4; j += 2) { const unsigned w = pk2(S[i][j] * e, S[i][j + 1] * e);
                *(LAS bf16_t*)(lds + L_S + ((16 * tr + 4 * fq + j) * P136 + n) * 2) = (bf16_t)(w & 0xffffu); *(LAS bf16_t*)(lds + L_S + ((16 * tr + 4 * fq + j + 1) * P136 + n) * 2) = (bf16_t)(w >> 16); } }
        bf16x8 xa[4];
        if (do_out) {
            f32x4 g0 = {0.f, 0.f, 0.f, 0.f}, g1 = {0.f, 0.f, 0.f, 0.f};
#pragma unroll
            for (int kk = 0; kk < 4; ++kk) { xa[kk] = LDF(bo + B_X1, 16 * tr + fr, 32 * kk + 8 * fq, P136); const bf16x8 b0 = LDF(bo + B_X2, 16 * tc0 + fr, 32 * kk + 8 * fq, P144), b1 = LDF(bo + B_X2, 16 * (tc0 + 1) + fr, 32 * kk + 8 * fq, P144);
                g0 = __builtin_amdgcn_mfma_f32_16x16x32_bf16(xa[kk], b0, g0, 0, 0, 0); g1 = __builtin_amdgcn_mfma_f32_16x16x32_bf16(xa[kk], b1, g1, 0, 0, 0); }
#pragma unroll
            for (int h = 0; h < 2; ++h) { const int s = 16 * (tc0 + h) + fr; float as = 0.f; if (KIND == 0) as = *(const LAS float*)(lds + bo + B_ACS + s * 4);
                float gm[4];
#pragma unroll
                for (int j = 0; j < 4; ++j) { const int t = 16 * tr + 4 * fq + j; float g = h ? g1[j] : g0[j];
                    if (KIND == 0) { const float at = *(const LAS float*)(lds + bo + B_ACS + t * 4); g *= __expf(fminf(at - as, 0.f)); }
                    gm[j] = (s <= t) ? g : 0.f; }
#pragma unroll
                for (int j = 0; j < 4; j += 2) { const int t = 16 * tr + 4 * fq + j; const unsigned w = pk2(gm[j], gm[j + 1]);
                    *(LAS bf16_t*)(lds + L_M + (t * P72 + s) * 2) = (bf16_t)(w & 0xffffu); *(LAS bf16_t*)(lds + L_M + ((t + 1) * P72 + s) * 2) = (bf16_t)(w >> 16); } }
        }
        SCAN_FLUSH();
        __syncthreads();
        if (do_out) {
            f32x4 z0 = {0.f, 0.f, 0.f, 0.f}, z1 = {0.f, 0.f, 0.f, 0.f};
#pragma unroll
            for (int kk = 0; kk < 4; ++kk) { const bf16x8 b0 = LDF(L_S, 16 * tc0 + fr, 32 * kk + 8 * fq, P136), b1 = LDF(L_S, 16 * (tc0 + 1) + fr, 32 * kk + 8 * fq, P136);
                z0 = __builtin_amdgcn_mfma_f32_16x16x32_bf16(xa[kk], b0, z0, 0, 0, 0); z1 = __builtin_amdgcn_mfma_f32_16x16x32_bf16(xa[kk], b1, z1, 0, 0, 0); }
            if (KIND == 0) {
#pragma unroll
                for (int j = 0; j < 4; ++j) { const float r = *(const LAS float*)(lds + bo + B_R + (16 * tr + 4 * fq + j) * 4); z0[j] *= r; z1[j] *= r; } }
#pragma unroll
            for (int kk = 0; kk < 2; ++kk) { const bf16x8 a = LDF(L_M, 16 * tr + fr, 32 * kk + 8 * fq, P72), b0 = trfrag(lds, bo + B_VA, P80, tc0, kk, lane), b1 = trfrag(lds, bo + B_VA, P80, tc0 + 1, kk, lane);
                z0 = __builtin_amdgcn_mfma_f32_16x16x32_bf16(a, b0, z0, 0, 0, 0); z1 = __builtin_amdgcn_mfma_f32_16x16x32_bf16(a, b1, z1, 0, 0, 0); }
#pragma unroll
            for (int j = 0; j < 4; ++j) { const int t = 16 * tr + 4 * fq + j; const unsigned w = pk2(z0[j], z1[j]);
                *(LAS bf16_t*)(lds + L_OUT + (t * P72 + 16 * tc0 + fr) * 2) = (bf16_t)(w & 0xffffu); *(LAS bf16_t*)(lds + L_OUT + (t * P72 + 16 * (tc0 + 1) + fr) * 2) = (bf16_t)(w >> 16); }
        }
        pend = do_out; pc = it.dir == 0 ? st - 1 : it.nC - 1 - st;
        {
            f32x4 d[4];
#pragma unroll
            for (int i = 0; i < 4; ++i) d[i] = (f32x4){0.f, 0.f, 0.f, 0.f};
#pragma unroll
            for (int kk = 0; kk < 2; ++kk) { const bf16x8 a = trfrag(lds, bo + (KIND == 0 ? B_VB : B_VA), P80, tr, kk, lane);
#pragma unroll
                for (int i = 0; i < 4; ++i) { const bf16x8 b = trfrag(lds, bo + B_X2, P144, nt0 + i, kk, lane); d[i] = __builtin_amdgcn_mfma_f32_16x16x32_bf16(a, b, d[i], 0, 0, 0); } }
#pragma unroll
            for (int i = 0; i < 4; ++i) { const int n = 16 * (nt0 + i) + fr; const float c1 = *(const LAS float*)(lds + bo + B_C1 + n * 4), c2 = *(const LAS float*)(lds + bo + B_C2 + n * 4);
#pragma unroll
                for (int j = 0; j < 4; ++j) S[i][j] = c1 * S[i][j] + c2 * d[i][j]; }
        }
        if (st + 1 < nSteps) { SCAN_PREP(BUFSZ - bo); if (st + 2 < nSteps) SCAN_LOAD(st + 2); }
    }
    __syncthreads();
    SCAN_FLUSH();
    __syncthreads();
#undef SCAN_FLUSH
#undef SCAN_PREP
#undef SCAN_LOAD
}

#define XB_TMO      128
#define XB_XCNT(j)  (256  + 64 * (j))
#define XB_XSUB(j)  (1280 + 64 * (j))
#define XB_XGEN(j)  (2304 + 64 * (j))
#define XB_TOP      3328
#define XB_TOPGEN   3392
#define XCD_BAR_WORDS 3456
#define XB_SPIN_CAP (1u << 22)
__device__ __forceinline__ unsigned xb_ld(unsigned* p)              { return __hip_atomic_load(p, __ATOMIC_RELAXED, __HIP_MEMORY_SCOPE_AGENT); }
__device__ __forceinline__ unsigned xb_add(unsigned* p, unsigned v) { return __hip_atomic_fetch_add(p, v, __ATOMIC_RELAXED, __HIP_MEMORY_SCOPE_AGENT); }
__device__ __forceinline__ unsigned xb_xcc_id() { return (unsigned)__builtin_amdgcn_s_getreg((3 << 11) | 20) & 0xFu; }
#define XB_SPIN(cond, bar) do { unsigned _sp = 0; while (cond) { __builtin_amdgcn_s_sleep(1); \
    if ((++_sp & 255u) == 0u) { if (xb_ld(&(bar)[XB_TMO])) break; if (_sp > XB_SPIN_CAP) { atomicAdd(&(bar)[XB_TMO], 1u); break; } } } } while (0)
struct XcdBarrier { unsigned* bar; unsigned x; volatile LAS unsigned* st; };
__device__ __forceinline__ XcdBarrier xcd_barrier_post(unsigned* bar, volatile LAS unsigned* st) {
    XcdBarrier b; b.bar = bar; b.x = xb_xcc_id(); b.st = st;
    if (threadIdx.x == 0) (void)xb_add(&bar[XB_XCNT(b.x)], 1u);
    return b;
}
__device__ __forceinline__ void xcd_barrier_complete(unsigned* bar, unsigned x, unsigned& nloc, unsigned& nx) {
    const unsigned G = gridDim.x * gridDim.y * gridDim.z;
    unsigned sum, cnt, mine, sp = 0u;
    for (;;) {
        sum = 0u; cnt = 0u; mine = 0u;
#pragma unroll
        for (unsigned j = 0; j < 16; ++j) { const unsigned c = xb_ld(&bar[XB_XCNT(j)]); sum += c; cnt += (c > 0u) ? 1u : 0u; mine = (j == x) ? c : mine; }
        if (sum == G) break;
        __builtin_amdgcn_s_sleep(1);
        if ((++sp & 255u) == 0u) { if (xb_ld(&bar[XB_TMO])) break; if (sp > XB_SPIN_CAP) { atomicAdd(&bar[XB_TMO], 1u); break; } }
    }
    nloc = mine > 0u ? mine : 1u; nx = cnt > 0u ? cnt : 1u;
}
__device__ __forceinline__ void xcd_barrier(const XcdBarrier& b) {
    asm volatile("s_waitcnt vmcnt(0)" ::: "memory");
    __syncthreads();
    if (threadIdx.x == 0) {
        unsigned* bar = b.bar;
        __builtin_amdgcn_s_waitcnt(0);
        unsigned nloc = b.st[0], nx = b.st[1];
        if (nloc == 0u) { xcd_barrier_complete(bar, b.x, nloc, nx); b.st[0] = nloc; b.st[1] = nx; }
        const unsigned old = xb_add(&bar[XB_XSUB(b.x)], 1u);
        const unsigned gen = old / nloc;
        if (old + 1u == (gen + 1u) * nloc) {
            __builtin_amdgcn_fence(__ATOMIC_RELEASE, "agent");
            asm volatile("s_waitcnt vmcnt(0)" ::: "memory");
            const unsigned og = xb_add(&bar[XB_TOP], 1u);
            const unsigned tg = og / nx;
            if (og + 1u == (tg + 1u) * nx) xb_add(&bar[XB_TOPGEN], 1u);
            else XB_SPIN(xb_ld(&bar[XB_TOPGEN]) == tg, bar);
            __builtin_amdgcn_fence(__ATOMIC_ACQUIRE, "agent");
            xb_add(&bar[XB_XGEN(b.x)], 1u);
            asm volatile("s_waitcnt vmcnt(0)" ::: "memory");
        } else {
            XB_SPIN(xb_ld(&bar[XB_XGEN(b.x)]) == gen, bar);
            __builtin_amdgcn_fence(__ATOMIC_ACQUIRE, "agent");
            asm volatile("s_waitcnt vmcnt(0)" ::: "memory");
        }
    }
    __syncthreads();
}

struct Params { const float* in[23]; float* out; unsigned char* ws; };

constexpr int LDS_BST = 152576;
constexpr int LDS_BYTES = 152832;

__global__ void __launch_bounds__(512, 2) fwd_mega(Params P) {
    extern __shared__ __attribute__((aligned(16))) unsigned char lds_raw[];
    LAS unsigned char* lds = (LAS unsigned char*)lds_raw;
    cg::grid_group grid = cg::this_grid();
    const int G = gridDim.x, bx = blockIdx.x;
#define WSD unsigned char* ws = P.ws; asm volatile("" : "+s"(ws)); unsigned char* dob = (unsigned char*)P.out; asm volatile("" : "+s"(dob)); (void)dob
    volatile LAS unsigned* bst = (volatile LAS unsigned*)(lds + LDS_BST);
    if (threadIdx.x < 2) bst[threadIdx.x] = 0u;
    __syncthreads();
    (void)xcd_barrier_post((unsigned*)(P.ws + WS_BAR), bst);
#define GSYNC do { XcdBarrier _xb; _xb.bar = (unsigned*)(P.ws + WS_BAR); _xb.x = xb_xcc_id(); _xb.st = (volatile LAS unsigned*)(lds + LDS_BST); xcd_barrier(_xb); } while (0)
#define IDS WSD; const int tid = fresh_tid(), lane = tid & 63, wave = __builtin_amdgcn_readfirstlane(tid >> 6), gw = bx * 8 + wave, NGW = G * 8, gt = bx * 512 + tid, NGT = G * 512; (void)lane; (void)gw; (void)NGW; (void)gt; (void)NGT
#define x_p (P.in[0])
#define x_s (P.in[1])
#define meta (P.in[2])
#define SS0 ((float*)(ws + WS_SS0))
#define SS1 ((float*)(ws + WS_SS1))
#define SS2 ((float*)(ws + WS_SS2))
#define SS3 ((float*)(ws + WS_SS3))
#define SSM0 ((float*)(ws + WS_SSM0))
#define SSM1 ((float*)(ws + WS_SSM1))
#define LBV ((float*)(ws + WS_LBV))
#define HBM ((bf16_t*)(ws + M_HBM))
#define ACTM ((bf16_t*)(ws + M_ACTM))
#define XBCM ((bf16_t*)(ws + M_XBCM))
#define QM ((bf16_t*)(ws + M_QM))
#define LOGFM ((bf16_t*)(ws + M_LOGFM))
#define VM ((bf16_t*)(ws + M_VM))
#define DTM ((float*)(ws + M_DTM))
#define XCM ((bf16_t*)(ws + M_XCM))
#define DT ((float*)(ws + WS_DT))
#define WGU1 ((bf16_t*)(ws + WS_WGU1))
#define WD1 ((bf16_t*)(ws + WS_WD1))
#define WGU2 ((bf16_t*)(ws + WS_WGU2))
#define WD2 ((bf16_t*)(ws + WS_WD2))
#define WPRE ((bf16_t*)(ws + WS_WPRE))
#define WPOST ((bf16_t*)(ws + WS_WPOST))
#define WA ((bf16_t*)(ws + WS_WA))
#define WB ((bf16_t*)(ws + WS_WB))
#define WOUT ((bf16_t*)(ws + WS_WOUT))
#define WDT ((bf16_t*)(ws + WS_WDT))
#define HB ((bf16_t*)(ws + WS_HB))
#define ACT0 ((bf16_t*)(ws + WS_F))
#define ACT1 ((bf16_t*)dob)
#define QB ((bf16_t*)(ws + WS_QB))
#define VB ((bf16_t*)(ws + WS_VB))
#define ZG ((bf16_t*)(ws + WS_ZG))
#define GATES ((bf16_t*)(ws + WS_GATES))
#define SA QB
#define SB VB
#define XBC ((bf16_t*)(dob + DO_Y))
#define YF ((bf16_t*)(dob + DO_Y))
#define YB ((bf16_t*)(dob + DO_Y + 16 * MiB))
#define XC ((bf16_t*)(dob + DO_XC))
#define LOGF ((bf16_t*)(dob + DO_LOGF))
#define PARK GATES
#define GATES2 ((bf16_t*)(dob))
#define MERGED2 ((bf16_t*)(dob + 64 * MiB))
#define OF ((bf16_t*)(dob + DO_OF))
#define OB ((bf16_t*)(dob + DO_OB))
#define QE1 ((bf16_t*)(ws + WS_QE1))
#define HSC ((float*)(ws + WS_HSC))

    {
        IDS;
        LAS float* scr = (LAS float*)(lds + wave * 16384);
        tr_job(P.in[4], 2 * DFF, DM, 0, 2 * DFF, WGU1, 0, 1, P.in[3], scr, gw, NGW, lane);
        tr_job(P.in[5], DM, DFF, 0, DM, WD1, 0, 0, nullptr, scr, gw, NGW, lane);
        tr_job(P.in[20], 2 * DFF, DM, 0, 2 * DFF, WGU2, 0, 1, P.in[19], scr, gw, NGW, lane);
        tr_job(P.in[21], DM, DFF, 0, DM, WD2, 0, 0, nullptr, scr, gw, NGW, lane);
        tr_job(P.in[7], IN_COLS, DM, 1024, 2048, WPRE, 0, 0, P.in[6], scr, gw, NGW, lane);
        tr_job(P.in[7], IN_COLS, DM, 3104, 1024, WPRE, 2048, 0, P.in[6], scr, gw, NGW, lane);
        tr_job(P.in[7], IN_COLS, DM, 4128, 2048, WPRE, 3072, 0, P.in[6], scr, gw, NGW, lane);
        tr_job(P.in[7], IN_COLS, DM, 6176, 1024, WPRE, 5120, 0, P.in[6], scr, gw, NGW, lane);
        tr_job(P.in[7], IN_COLS, DM, 3072, 32, WDT, 0, 0, P.in[6], scr, gw, NGW, lane);
        tr_job(P.in[7], IN_COLS, DM, 0, 1024, WPOST, 0, 0, P.in[6], scr, gw, NGW, lane);
        tr_job(P.in[7], IN_COLS, DM, 7200, 1024, WPOST, 1024, 0, P.in[6], scr, gw, NGW, lane);
        tr_job(P.in[7], IN_COLS, DM, 8224, 2048, WPOST, 2048, 0, P.in[6], scr, gw, NGW, lane);
        tr_job(P.in[14], DM, DM, 0, DM, WA, 0, 0, P.in[13], scr, gw, NGW, lane);
        tr_job(P.in[17], DM, DM, 0, DM, WB, 0, 0, P.in[16], scr, gw, NGW, lane);
        tr_job(P.in[18], DM, DM, 0, DM, WOUT, 0, 0, nullptr, scr, gw, NGW, lane);
        for (int r = gw; r < NTOK + 16; r += NGW) {
            const bool ism = r >= NTOK; const int rr = ism ? r - NTOK : r;
            const float* xr = ism ? meta + (size_t)rr * DM : (rr < NP_ROWS ? x_p + (size_t)rr * DM : x_s + (size_t)(rr - NP_ROWS) * DM);
            bf16_t* orow = ism ? HBM + (size_t)rr * DM : HB + (size_t)rr * DM;
            float s = 0.f;
#pragma unroll
            for (int j = 0; j < 4; ++j) { const f32x4 v = *(const f32x4*)(xr + 4 * lane + 256 * j); s += (v[0] * v[0] + v[1] * v[1]) + (v[2] * v[2] + v[3] * v[3]);
                *(unsigned long long*)(orow + 4 * lane + 256 * j) = (unsigned long long)pk2(v[0], v[1]) | ((unsigned long long)pk2(v[2], v[3]) << 32); }
            s = wave_sum(s);
            if (lane == 0) { if (ism) SSM0[rr] = s; else SS0[rr] = s; }
        }
        for (int i = gt; i < NTOK; i += NGT) { SS1[i] = 0.f; SS2[i] = 0.f; SS3[i] = 0.f; }
        if (gt < 16) SSM1[gt] = 0.f;
        for (int i = gt; i < 2048; i += NGT) { const int d = i >> 10, w = i & 1023; const float* t = P.in[15]; LBV[i] = fsigmoid(t[d * 2048 + w] - t[d * 2048 + 1024 + w]); }
    }
    grid.sync();

    {
        IDS;
        if (gw < 176) {
            const int j0 = 16 * gw, brow = (j0 / 128) * 256 + (j0 % 128);
            const f32x4 ag = sg16(HBM, DM, WGU1 + (size_t)brow * DM, DM, lane), au = sg16(HBM, DM, WGU1 + (size_t)(brow + 128) * DM, DM, lane);
#pragma unroll
            for (int j = 0; j < 4; ++j) { const int row = 4 * (lane >> 4) + j; const float s = __builtin_amdgcn_rsqf(SSM0[row] * (1.f / DM) + EPS);
                ACTM[(size_t)row * DFF + j0 + (lane & 15)] = (bf16_t)f2bf(fsilu(ag[j] * s) * (au[j] * s)); }
        }
        pg8::Gemm g{HB, WGU1, NTOK, 2 * DFF, DM}; pg8::StaticOrder S; S.init(NTOK, 2 * DFF, G, bx);
        pg8::EpiGU E{ACT0, ACT1, NP_ROWS, SS0, 0};
        pg8::gemm_phase<pg8::EpiGU, pg8::StaticOrder, true, true>(lds, g, S, E);
    }
    GSYNC;
    {
        IDS;
        if (gw < 64) {
            const f32x4 a = sg16(ACTM, DFF, WD1 + (size_t)(16 * gw) * DFF, DFF, lane);
#pragma unroll
            for (int j = 0; j < 4; ++j) { const int row = 4 * (lane >> 4) + j, col = 16 * gw + (lane & 15); const float v = meta[(size_t)row * DM + col] + 0.5f * a[j];
                HBM[(size_t)row * DM + col] = (bf16_t)f2bf(v); float sq = v * v; sq += __shfl_xor(sq, 1); sq += __shfl_xor(sq, 2); sq += __shfl_xor(sq, 4); sq += __shfl_xor(sq, 8);
                if ((lane & 15) == 0) atomicAdd(SSM1 + row, sq); }
        }
#pragma unroll 1
        for (int h = 0; h < 2; ++h) {
            pg8::Gemm g{h ? ACT1 : ACT0, WD1, NP_ROWS, DM, DFF}; pg8::StaticOrder S; S.init(NP_ROWS, DM, G, bx);
            pg8::EpiRes<0, 0> E{x_p, x_s, HB, nullptr, 0.5f, SS1, h * NP_ROWS};
            pg8::gemm_phase<pg8::EpiRes<0, 0>, pg8::StaticOrder, true, true>(lds, g, S, E);
        }
    }
    GSYNC;

#if STAGE >= 2
#pragma unroll 1
    for (int grp = 0; grp < NGROUPS; ++grp) {
        const int grow0 = grp * GROUP_ROWS;
        const int nseq = grp < 2 ? 4 : 2, SL = grp < 2 ? 2048 : 4096;
        {
            IDS;
            if (grp == 0) {
                for (int t = gw; t < 384 + 2; t += NGW) {
                    if (t < 384) {
                        const int c0 = 16 * t; const f32x4 a = sg16(HBM, DM, WPRE + (size_t)c0 * DM, DM, lane);
#pragma unroll
                        for (int j = 0; j < 4; ++j) { const int row = 4 * (lane >> 4) + j, c = c0 + (lane & 15); const float v = a[j] * __builtin_amdgcn_rsqf(SSM1[row] * (1.f / DM) + EPS);
                            if (c < 2048) XBCM[row * 2048 + c] = (bf16_t)f2bf(v);
                            else if (c < 3072) QM[row * 1024 + c - 2048] = (bf16_t)f2bf(fsilu(v));
                            else if (c < 5120) { const float lb = LBV[c - 3072]; const float f = lb + (1.f - lb) * fsigmoid(v); LOGFM[row * 2048 + c - 3072] = (bf16_t)(pkh2(__logf(f), 0.f) & 0xffffu); }
                            else VM[row * 1024 + c - 5120] = (bf16_t)f2bf(v); }
                    } else {
                        const int c0 = 16 * (t - 384); const f32x4 a = sg16(HBM, DM, WDT + (size_t)c0 * DM, DM, lane);
#pragma unroll
                        for (int j = 0; j < 4; ++j) { const int row = 4 * (lane >> 4) + j, c = c0 + (lane & 15); const float v = a[j] * __builtin_amdgcn_rsqf(SSM1[row] * (1.f / DM) + EPS) + P.in[10][c];
                            DTM[row * 32 + c] = v > 15.f ? v : log1pf(__expf(v)); }
                    }
                }
            }
            for (int t = gw; t < 1024; t += NGW) {
                const int rt = t >> 1, c0 = 16 * (t & 1), r0 = grow0 + 16 * rt;
                const f32x4 a = sg16(HB + (size_t)r0 * DM, DM, WDT + (size_t)c0 * DM, DM, lane);
#pragma unroll
                for (int j = 0; j < 4; ++j) { const int row = r0 + 4 * (lane >> 4) + j, c = c0 + (lane & 15); const float v = a[j] * __builtin_amdgcn_rsqf(SS1[row] * (1.f / DM) + EPS) + P.in[10][c];
                    DT[(size_t)row * 32 + c] = v > 15.f ? v : log1pf(__expf(v)); }
            }
            pg8::Gemm g{HB + (size_t)grow0 * DM, WPRE, GROUP_ROWS, NPRE, DM}; pg8::StaticOrder S; S.init(GROUP_ROWS, NPRE, G, bx);
            pg8::EpiPre E{XBC, QB, LOGF, VB, SS1, LBV, grow0};
            pg8::gemm_phase<pg8::EpiPre, pg8::StaticOrder, true, true>(lds, g, S, E);
        }
        GSYNC;
        {
            IDS;
            const float* cw = P.in[8]; const float* cb = P.in[9];
#pragma unroll 1
            for (int pass = 0; pass < 2; ++pass) {
            if (((pass ^ (wave >> 2)) & 1) == 0) {
            for (int task = gt; task < (GROUP_ROWS / 16) * 256; task += NGT) {
                const int cgp = task & 255, rb = task >> 8, c = 8 * cgp, t0 = 16 * rb, seq0 = (t0 / SL) * SL, tl0 = t0 - seq0;
                float w[5][8], bias[8];
#pragma unroll
                for (int j = 0; j < 5; ++j) { const f32x4 a = *(const f32x4*)(cw + j * 2048 + c), b = *(const f32x4*)(cw + j * 2048 + c + 4); w[j][0] = a[0]; w[j][1] = a[1]; w[j][2] = a[2]; w[j][3] = a[3]; w[j][4] = b[0]; w[j][5] = b[1]; w[j][6] = b[2]; w[j][7] = b[3]; }
                { const f32x4 a = *(const f32x4*)(cb + c), b = *(const f32x4*)(cb + c + 4); bias[0] = a[0]; bias[1] = a[1]; bias[2] = a[2]; bias[3] = a[3]; bias[4] = b[0]; bias[5] = b[1]; bias[6] = b[2]; bias[7] = b[3]; }
                float win[5][8];
#define CONV_LD(dst, tau) do { const int _t = (tau); u32x4 _w = {0u, 0u, 0u, 0u}; \
                    if (_t < 0) _w = *(const u32x4*)(XBCM + (size_t)(16 + _t) * 2048 + c); else if (_t < SL) _w = *(const u32x4*)(XBC + (size_t)(seq0 + _t) * 2048 + c); \
                    unpack8(_w, dst); } while (0)
                CONV_LD(win[0], tl0 - 2); CONV_LD(win[1], tl0 - 1); CONV_LD(win[2], tl0); CONV_LD(win[3], tl0 + 1);
#pragma unroll
                for (int i = 0; i < 16; ++i) {
                    CONV_LD(win[4], tl0 + i + 2);
                    float o[8];
#pragma unroll
                    for (int e = 0; e < 8; ++e) { float a = bias[e];
#pragma unroll
                        for (int j = 0; j < 5; ++j) a += w[j][e] * win[j][e];
                        o[e] = fsilu(a); }
                    *(u32x4*)(XC + (size_t)(t0 + i) * 2048 + c) = pack8(o);
#pragma unroll
                    for (int j = 0; j < 4; ++j)
#pragma unroll
                        for (int e = 0; e < 8; ++e) win[j][e] = win[j + 1][e];
                }
            }
            for (int task = gt; task < nseq * 16 * 256; task += NGT) {
                const int cgp = task & 255, m = (task >> 8) & 15, sq = task >> 12, c = 8 * cgp, seq0 = sq * SL;
                const int sg = grp < 2 ? grp * 4 + sq : 8 + (grp - 2) * 2 + sq;
                float a[8];
                { const f32x4 b0 = *(const f32x4*)(cb + c), b1 = *(const f32x4*)(cb + c + 4); a[0] = b0[0]; a[1] = b0[1]; a[2] = b0[2]; a[3] = b0[3]; a[4] = b1[0]; a[5] = b1[1]; a[6] = b1[2]; a[7] = b1[3]; }
#pragma unroll
                for (int j = 0; j < 5; ++j) { const int mm = m + j - 2; if (mm < 0) continue;
                    const u32x4 wv_ = mm < 16 ? *(const u32x4*)(XBCM + (size_t)mm * 2048 + c) : *(const u32x4*)(XBC + (size_t)(seq0 + mm - 16) * 2048 + c);
                    float xv[8]; unpack8(wv_, xv); const f32x4 w0 = *(const f32x4*)(cw + j * 2048 + c), w1 = *(const f32x4*)(cw + j * 2048 + c + 4);
                    a[0] += w0[0] * xv[0]; a[1] += w0[1] * xv[1]; a[2] += w0[2] * xv[2]; a[3] += w0[3] * xv[3]; a[4] += w1[0] * xv[4]; a[5] += w1[1] * xv[5]; a[6] += w1[2] * xv[6]; a[7] += w1[3] * xv[7]; }
#pragma unroll
                for (int e = 0; e < 8; ++e) a[e] = fsilu(a[e]);
                *(u32x4*)(XCM + ((size_t)sg * 16 + m) * 2048 + c) = pack8(a);
            }
            } else {
            for (int unit = gw; unit < (GROUP_ROWS / 64) * 128; unit += NGW) {
                const int j = unit & 127, ch = unit >> 7; const size_t row = (size_t)ch * 64 + lane;
                const u32x4 qw = *(const u32x4*)(QB + row * 1024 + 8 * j), l0 = *(const u32x4*)(LOGF + row * 2048 + 8 * j), l1 = *(const u32x4*)(LOGF + row * 2048 + 1024 + 8 * j);
                float qv[8], x0[8], x1[8], qe0[8], ke0[8], qe1[8], ke1[8]; unpack8(qw, qv);
                x0[0] = hlo(l0.x); x0[1] = hhi(l0.x); x0[2] = hlo(l0.y); x0[3] = hhi(l0.y); x0[4] = hlo(l0.z); x0[5] = hhi(l0.z); x0[6] = hlo(l0.w); x0[7] = hhi(l0.w);
                x1[0] = hlo(l1.x); x1[1] = hhi(l1.x); x1[2] = hlo(l1.y); x1[3] = hhi(l1.y); x1[4] = hlo(l1.z); x1[5] = hhi(l1.z); x1[6] = hlo(l1.w); x1[7] = hhi(l1.w);
                float* hs = HSC + (size_t)ch * 6144 + 8 * j; float t0s = 0.f, r0s = 0.f, t1s = 0.f, r1s = 0.f;
#pragma unroll
                for (int e = 0; e < 8; ++e) {
                    const float p0 = wave_scan(x0[e], lane), tot0 = lane_bcast(p0, 63), ref0 = lane_bcast(p0, 31);
                    qe0[e] = qv[e] * __expf(p0 - ref0); ke0[e] = (1.f - __expf(x0[e])) * __expf(ref0 - p0);
                    const float p1 = wave_scan(x1[e], lane), tot1 = lane_bcast(p1, 63), b1 = tot1 - p1 + x1[e], ref1 = lane_bcast(b1, 32);
                    qe1[e] = qv[e] * __expf(b1 - ref1); ke1[e] = (1.f - __expf(x1[e])) * __expf(ref1 - b1);
                    if (lane == e) { t0s = tot0; r0s = ref0; t1s = tot1; r1s = ref1; }
                }
                if (lane < 8) { hs[lane] = __expf(t0s); hs[2048 + lane] = __expf(t0s - r0s); hs[4096 + lane] = __expf(r0s);
                                hs[1024 + lane] = __expf(t1s); hs[2048 + 1024 + lane] = __expf(t1s - r1s); hs[4096 + 1024 + lane] = __expf(r1s); }
                *(u32x4*)(QB + row * 1024 + 8 * j) = pack8(qe0); *(u32x4*)(QE1 + row * 1024 + 8 * j) = pack8(qe1);
                *(u32x4*)(LOGF + row * 2048 + 8 * j) = pack8(ke0); *(u32x4*)(LOGF + row * 2048 + 1024 + 8 * j) = pack8(ke1);
            }
            }
            }
#undef CONV_LD
        }
        GSYNC;
        {
            WSD;
            const int nitems = nseq * 64;
#pragma unroll 1
            for (int item = bx; item < nitems; item += G) {
                ScanItem it; const int half = nseq * 32; it.kind = item / half; const int rem = item % half, sq = rem / 32, r2 = rem % 32;
                const int sg = grp < 2 ? grp * 4 + sq : 8 + (grp - 2) * 2 + sq;
                it.nC = SL / 64; it.row0 = sq * SL; it.grow0 = grow0 + sq * SL;
                it.xc = XC; it.xcm = XCM + (size_t)sg * 16 * 2048; it.dt = DT; it.dtm = DTM; it.q = QB; it.logf = LOGF; it.v = VB; it.logfm = LOGFM; it.vm = VM;
                if (it.kind == 0) { it.head = r2 >> 1; it.dir = r2 & 1; it.vh = 0; it.Aneg = -__expf(P.in[11][it.dir * 16 + it.head]); it.out = it.dir ? YB : YF; it.ocol = it.head * 64;
                    it.dtm = DTM + it.dir * 16; scan_run<0>(lds, it); }
                else { it.head = r2 >> 2; it.dir = (r2 >> 1) & 1; it.vh = r2 & 1; it.Aneg = 0.f; it.out = it.dir ? OB : OF; it.ocol = it.head * 128 + it.vh * 64;
                    it.logfm = LOGFM + it.dir * 1024; it.q = it.dir ? QE1 : QB; it.hsc = HSC; scan_run<1>(lds, it); }
            }
            const int gp = nitems >= G ? G : G - nitems, cp = nitems >= G ? bx : bx - nitems;
            pg8::Gemm g{HB + (size_t)grow0 * DM, WPOST, GROUP_ROWS, NPOST / 2, DM}; pg8::StaticOrder S; S.init(GROUP_ROWS, NPOST / 2, gp, cp);
            pg8::EpiPost E{ZG, SS1, grow0, 0};
            pg8::gemm_phase<pg8::EpiPost, pg8::StaticOrder, true, true>(lds, g, S, E);
        }
        GSYNC;
        {
            IDS;
            const float* dsk = P.in[12];
            bf16_t* const sa = (grp & 1) ? SA : PARK; bf16_t* const sb = (grp & 1) ? SB : PARK + (size_t)GROUP_ROWS * DM;
            for (int r = gw; r < GROUP_ROWS; r += NGW) {
                float ya[2][8], oa[2][8]; float ssq = 0.f;
#pragma unroll
                for (int j = 0; j < 2; ++j) { const int c = 8 * lane + 512 * j; float yf[8], yb[8], xs[8], zz[8];
                    unpack8(*(const u32x4*)(YF + (size_t)r * 1024 + c), yf); unpack8(*(const u32x4*)(YB + (size_t)r * 1024 + c), yb);
                    unpack8(*(const u32x4*)(XC + (size_t)r * 2048 + c), xs); unpack8(*(const u32x4*)(ZG + (size_t)r * 2048 + c), zz);
                    const float dk = dsk[c >> 6];
#pragma unroll
                    for (int e = 0; e < 8; ++e) { const float v = (yf[e] + yb[e] + dk * xs[e]) * zz[e]; ya[j][e] = v; ssq += v * v; } }
                ssq = wave_sum(ssq); const float rstd = __builtin_amdgcn_rsqf(ssq * (1.f / DM) + EPS);
#pragma unroll
                for (int j = 0; j < 2; ++j) { const int c = 8 * lane + 512 * j; float of[8], ob[8], hg[8]; float hs = 0.f;
                    unpack8(*(const u32x4*)(OF + (size_t)r * 1024 + c), of); unpack8(*(const u32x4*)(OB + (size_t)r * 1024 + c), ob); unpack8(*(const u32x4*)(ZG + (size_t)r * 2048 + 1024 + c), hg);
#pragma unroll
                    for (int e = 0; e < 8; ++e) { const float v = of[e] + ob[e]; oa[j][e] = v; hs += v * v; }
                    hs += __shfl_xor(hs, 1); hs += __shfl_xor(hs, 2); hs += __shfl_xor(hs, 4); hs += __shfl_xor(hs, 8);
                    const float hr = __builtin_amdgcn_rsqf(hs * (1.f / 128.f) + EPS);
#pragma unroll
                    for (int e = 0; e < 8; ++e) oa[j][e] = oa[j][e] * hr * hg[e]; }
#pragma unroll
                for (int j = 0; j < 2; ++j) { const int c = 8 * lane + 512 * j;
#pragma unroll
                    for (int e = 0; e < 8; ++e) ya[j][e] *= rstd;
                    *(u32x4*)(sa + (size_t)r * 1024 + c) = pack8(ya[j]); *(u32x4*)(sb + (size_t)r * 1024 + c) = pack8(oa[j]); }
            }
        }
        GSYNC;
        if (grp & 1) {
            const int prow0 = (grp - 1) * GROUP_ROWS;
            {
                WSD;
                pg8::Gemm g{HB + (size_t)prow0 * DM, WPOST + (size_t)(NPOST / 2) * DM, 2 * GROUP_ROWS, NPOST / 2, DM}; pg8::StaticOrder S; S.init(2 * GROUP_ROWS, NPOST / 2, G, bx);
                pg8::EpiPost E{GATES2, SS1, prow0, 1};
                pg8::gemm_phase<pg8::EpiPost, pg8::StaticOrder, true, true>(lds, g, S, E);
            }
            GSYNC;
            {
                WSD;
#pragma unroll 1
                for (int gi = 0; gi < 2; ++gi) {
                    const bf16_t* sa = gi ? SA : PARK; const bf16_t* sb = gi ? SB : PARK + (size_t)GROUP_ROWS * DM; const int c = (bx + gi * (G / 2)) % G;
                    { pg8::Gemm g{sa, WA, GROUP_ROWS, DM, DM}; pg8::StaticOrder S; S.init(GROUP_ROWS, DM, G, c); pg8::EpiMerge<1> E{MERGED2, GATES2, gi * GROUP_ROWS};
                      pg8::gemm_phase<pg8::EpiMerge<1>, pg8::StaticOrder, true, true>(lds, g, S, E); }
                    { pg8::Gemm g{sb, WB, GROUP_ROWS, DM, DM}; pg8::StaticOrder S; S.init(GROUP_ROWS, DM, G, c); pg8::EpiMerge<0> E{MERGED2, GATES2, gi * GROUP_ROWS};
                      pg8::gemm_phase<pg8::EpiMerge<0>, pg8::StaticOrder, true, true>(lds, g, S, E); }
                }
            }
            GSYNC;
            {
                WSD;
                pg8::Gemm g{MERGED2, WOUT, 2 * GROUP_ROWS, DM, DM}; pg8::StaticOrder S; S.init(2 * GROUP_ROWS, DM, G, bx);
                pg8::EpiRes<1, 0> E{nullptr, nullptr, HB, nullptr, 1.0f, SS2, prow0};
                pg8::gemm_phase<pg8::EpiRes<1, 0>, pg8::StaticOrder, true, true>(lds, g, S, E);
            }
            GSYNC;
        }
    }
#define SSF SS2
#else
#define SSF SS1
#endif

#pragma unroll 1
    for (int h = 0; h < 2; ++h) {
        {
            WSD;
            pg8::Gemm g{HB + (size_t)h * NP_ROWS * DM, WGU2, NP_ROWS, 2 * DFF, DM}; pg8::StaticOrder S; S.init(NP_ROWS, 2 * DFF, G, bx);
            pg8::EpiGU E{ACT0, ACT0, NP_ROWS, SSF, h * NP_ROWS};
            pg8::gemm_phase<pg8::EpiGU, pg8::StaticOrder, true, true>(lds, g, S, E);
        }
        GSYNC;
        {
            WSD;
            pg8::Gemm g{ACT0, WD2, NP_ROWS, DM, DFF}; pg8::StaticOrder S; S.init(NP_ROWS, DM, G, bx);
            pg8::EpiRes<1, 1> E{nullptr, nullptr, HB, P.out, 0.5f, SS3, h * NP_ROWS};
            pg8::gemm_phase<pg8::EpiRes<1, 1>, pg8::StaticOrder, true, true>(lds, g, S, E);
        }
        GSYNC;
    }
    {
        IDS;
        const float* fw = P.in[22];
        for (int r = gw; r < NTOK; r += NGW) {
            const float rstd = __builtin_amdgcn_rsqf(SS3[r] * (1.f / DM) + EPS); float* o = P.out + (size_t)r * DM;
#pragma unroll
            for (int j = 0; j < 4; ++j) { const int c = 4 * lane + 256 * j; f32x4 v = *(const f32x4*)(o + c); const f32x4 w = *(const f32x4*)(fw + c);
                v[0] *= rstd * w[0]; v[1] *= rstd * w[1]; v[2] *= rstd * w[2]; v[3] *= rstd * w[3]; *(f32x4*)(o + c) = v; }
        }
    }
}

extern "C" void kernel_launch(void* const* d_in, const int* in_sizes, int n_in, void* d_out, int out_size, void* d_ws, size_t ws_size, hipStream_t stream) {
    static int grid = 0;
    if (grid == 0) {
        if (n_in != 23 || out_size != NTOK * DM || ws_size < WS_END) { fprintf(stderr, "kernel_launch: unexpected shapes (n_in %d out %d ws %zu)\n", n_in, out_size, ws_size); grid = -1; return; }
        int dev = 0, cus = 0, per_cu = 0;
        hipGetDevice(&dev); hipDeviceGetAttribute(&cus, hipDeviceAttributeMultiprocessorCount, dev);
        hipFuncSetAttribute((const void*)fwd_mega, hipFuncAttributeMaxDynamicSharedMemorySize, LDS_BYTES);
        hipOccupancyMaxActiveBlocksPerMultiprocessor(&per_cu, (const void*)fwd_mega, 512, LDS_BYTES);
        if (per_cu < 1) { fprintf(stderr, "kernel_launch: occupancy query says %d blocks per CU\n", per_cu); grid = -1; return; }
        grid = cus;
    }
    if (grid < 0) return;
    Params p{};
    for (int i = 0; i < 23; ++i) p.in[i] = (const float*)d_in[i];
    p.out = (float*)d_out; p.ws = (unsigned char*)d_ws;
    (void)hipMemsetAsync((unsigned char*)d_ws + WS_BAR, 0, 16384, stream);
    void* args[] = {&p};
    hipError_t e = hipLaunchCooperativeKernel((const void*)fwd_mega, dim3(grid), dim3(512), args, LDS_BYTES, stream);
    if (e != hipSuccess) fprintf(stderr, "cooperative launch failed: %s (grid %d)\n", hipGetErrorString(e), grid);
}
```

```cpp
#include <hip/hip_runtime.h>
#include <hip/hip_cooperative_groups.h>
#include <cstdio>
#include <cstdint>
namespace cg = cooperative_groups;

#ifndef STAGE
#define STAGE 99
#endif

#define LAS __attribute__((address_space(3)))
typedef unsigned short bf16_t;
typedef short bf16x8 __attribute__((ext_vector_type(8)));
typedef float f32x4 __attribute__((ext_vector_type(4)));
typedef unsigned u32x4 __attribute__((ext_vector_type(4)));

constexpr int DM = 1024, DFF = 2816, NTOK = 32768, NP_ROWS = 16384;
constexpr int GROUP_ROWS = 8192, NGROUPS = 4;
constexpr float EPS = 1e-6f;
constexpr int IN_COLS = 10272;
constexpr int NPRE = 6144, NPOST = 4096;

constexpr size_t MiB = 1u << 20;
constexpr size_t WS_SS0 = 0, WS_SS1 = 128 * 1024, WS_SS2 = 256 * 1024, WS_SS3 = 384 * 1024, WS_SSM0 = 512 * 1024, WS_SSM1 = 512 * 1024 + 256, WS_LBV = 520 * 1024;
constexpr size_t WS_BAR = 640 * 1024;
constexpr size_t WS_META = 1 * MiB;
constexpr size_t M_HBM = WS_META, M_ACTM = WS_META + 32 * 1024, M_XBCM = WS_META + 128 * 1024, M_QM = WS_META + 192 * 1024, M_LOGFM = WS_META + 224 * 1024,
                 M_VM = WS_META + 288 * 1024, M_DTM = WS_META + 320 * 1024, M_XCM = WS_META + 324 * 1024;
constexpr size_t WS_DT = 3 * MiB;
constexpr size_t WS_WGU1 = 7 * MiB, WS_WD1 = 18 * MiB, WS_WGU2 = 23 * MiB + 512 * 1024, WS_WD2 = 34 * MiB + 512 * 1024, WS_WPRE = 40 * MiB, WS_WPOST = 52 * MiB,
                 WS_WA = 60 * MiB, WS_WB = 62 * MiB, WS_WOUT = 64 * MiB, WS_WDT = 66 * MiB;
constexpr size_t WS_HB = 67 * MiB;
constexpr size_t WS_F = 131 * MiB;
constexpr size_t WS_QB = WS_F, WS_VB = WS_F + 16 * MiB, WS_ZG = WS_F + 32 * MiB, WS_GATES = WS_F + 64 * MiB;
constexpr size_t WS_QE1 = 227 * MiB, WS_HSC = 243 * MiB;
constexpr size_t WS_END = 256 * MiB;
constexpr size_t DO_Y = 0, DO_XC = 32 * MiB, DO_LOGF = 64 * MiB, DO_OF = 96 * MiB, DO_OB = 112 * MiB;

__device__ __forceinline__ unsigned f2bf(float f) { unsigned u = __builtin_bit_cast(unsigned, f); return (u + 0x7fffu + ((u >> 16) & 1u)) >> 16; }
typedef float f32x2_t __attribute__((ext_vector_type(2)));
typedef __bf16 bf16x2_t __attribute__((ext_vector_type(2)));
__device__ __forceinline__ unsigned pk2(float lo, float hi) { const f32x2_t v = {lo, hi}; const bf16x2_t b = __builtin_convertvector(v, bf16x2_t); return __builtin_bit_cast(unsigned, b); }
__device__ __forceinline__ float bflo(unsigned w) { return __builtin_bit_cast(float, w << 16); }
__device__ __forceinline__ float bfhi(unsigned w) { return __builtin_bit_cast(float, w & 0xffff0000u); }
__device__ __forceinline__ float bf2f(bf16_t h) { return __builtin_bit_cast(float, ((unsigned)h) << 16); }
__device__ __forceinline__ float frcp(float x) { return __builtin_amdgcn_rcpf(x); }
__device__ __forceinline__ float fsigmoid(float x) { return frcp(1.f + __expf(-x)); }
__device__ __forceinline__ float fsilu(float x) { return x * frcp(1.f + __expf(-x)); }
__device__ __forceinline__ unsigned pkh2(float lo, float hi) { _Float16 a = (_Float16)lo, b = (_Float16)hi; return (unsigned)__builtin_bit_cast(unsigned short, a) | ((unsigned)__builtin_bit_cast(unsigned short, b) << 16); }
__device__ __forceinline__ float hlo(unsigned w) { return (float)__builtin_bit_cast(_Float16, (unsigned short)(w & 0xffffu)); }
__device__ __forceinline__ float hhi(unsigned w) { return (float)__builtin_bit_cast(_Float16, (unsigned short)(w >> 16)); }
__device__ __forceinline__ int fresh_tid() { int t = threadIdx.x; asm volatile("" : "+v"(t)); return t; }
__device__ __forceinline__ float wave_sum(float v) {
#pragma unroll
    for (int o = 1; o < 64; o <<= 1) v += __shfl_xor(v, o);
    return v;
}
template <int CTRL, int RM> __device__ __forceinline__ float dppmov(float v) { return __builtin_bit_cast(float, __builtin_amdgcn_update_dpp(0, __builtin_bit_cast(int, v), CTRL, RM, 0xf, false)); }
__device__ __forceinline__ float wave_scan(float v, int) {
    v += dppmov<0x111, 0xf>(v); v += dppmov<0x112, 0xf>(v); v += dppmov<0x114, 0xf>(v); v += dppmov<0x118, 0xf>(v);
    v += dppmov<0x142, 0xa>(v); v += dppmov<0x143, 0xc>(v);
    return v;
}
__device__ __forceinline__ float lane_bcast(float v, int l) { return __builtin_bit_cast(float, __builtin_amdgcn_readlane(__builtin_bit_cast(int, v), l)); }
__device__ __forceinline__ void unpack8(const u32x4 w, float (&f)[8]) {
    f[0] = bflo(w.x); f[1] = bfhi(w.x); f[2] = bflo(w.y); f[3] = bfhi(w.y); f[4] = bflo(w.z); f[5] = bfhi(w.z); f[6] = bflo(w.w); f[7] = bfhi(w.w);
}
__device__ __forceinline__ u32x4 pack8(const float (&f)[8]) { u32x4 w; w.x = pk2(f[0], f[1]); w.y = pk2(f[2], f[3]); w.z = pk2(f[4], f[5]); w.w = pk2(f[6], f[7]); return w; }

namespace pg8 {
#define PG8_LAS __attribute__((address_space(3)))
constexpr int BM = 256, BK = 64, HALF = 128, HTB = HALF * BK * 2, STAGE_BYTES = 8 * HTB, NXCD = 8, WGM = 8;
__host__ __device__ __forceinline__ int lds_byte(int r, int c) { const int st = (r >> 4) * 2 + (c >> 5), rr = r & 15, cc = c & 31, ob = rr * 64 + cc * 2; return st * 1024 + (ob ^ (((ob >> 9) & 1) << 5)); }
__host__ __device__ __forceinline__ void stage_rc(int b, int& R, int& C) { const int st = b / 1024, sb = b % 1024, swz = sb ^ (((sb >> 9) & 1) << 5); R = (st >> 1) * 16 + swz / 64; C = (st & 1) * 32 + (swz % 64) / 2; }
__host__ __device__ __forceinline__ int perm32(int rho) { const int n = rho >> 4, i = rho & 15; return 8 * (i >> 2) + 4 * n + (i & 3); }
struct Unit { int pm, pn; };
struct Gemm { const bf16_t* A; const bf16_t* Bt; int M, N, K; };
struct StaticOrder {
    int nM, nN, nwg, G, c;
    __device__ void init(int M, int N, int G_, int c_) { nM = M / BM; nN = N / BM; nwg = nM * nN; G = G_; c = c_; }
    __device__ bool next(int i, Unit& u) const {
        if (c < 0) return false;
        const long L = (long)i * G + c; if (L >= nwg) return false;
        int wgid = (int)L; { const int q = nwg / NXCD, r = nwg % NXCD, xcd = wgid % NXCD, off = wgid / NXCD; wgid = (xcd < r ? xcd * (q + 1) : r * (q + 1) + (xcd - r) * q) + off; }
        const int nig = WGM * nN, gid = wgid / nig, fm = gid * WGM, gsz = (nM - fm) < WGM ? (nM - fm) : WGM;
        u.pm = fm + ((wgid % nig) % gsz); u.pn = (wgid % nig) / gsz; return true;
    }
    __device__ __forceinline__ void a_ready(const Unit&) const {}
    __device__ __forceinline__ void done(const Unit&) const {}
};

template <class Epi, class Sched, bool ALIGN_EPI = false, bool SP2 = false>
__device__ __forceinline__ void gemm_phase(PG8_LAS unsigned char* lds, const Gemm g, const Sched& S, const Epi& E) {
    const int tid = fresh_tid(), wid = __builtin_amdgcn_readfirstlane(tid >> 6), lane = tid & 63, wr = wid >> 2, wc = wid & 3, fr = lane & 15, fq = lane >> 4;
    const int K = g.K, nt = K / BK;
    unsigned voffA[2], voffB[2];
#pragma unroll
    for (int i = 0; i < 2; ++i) { int R, C; stage_rc(tid * 16 + i * 8192, R, C); const int Rb = Epi::PERM ? ((R & ~31) + perm32(R & 31)) : R;
        voffA[i] = (unsigned)(R * K + C) * 2u; voffB[i] = (unsigned)(Rb * K + C) * 2u; }
    const size_t kstep = (size_t)(BK * 2);
    const size_t hstep = (size_t)HALF * K * 2;
    const size_t tstep = 2 * hstep;
    const unsigned ldsw = (unsigned)wid * 1024u;
    const int aoff = lds_byte(wr * 64 + fr, fq * 8), boff = lds_byte(wc * 32 + fr, fq * 8);
#define PG8_SA(b, h) (((b) * 2 + (h)) * HTB)
#define PG8_SB(b, h) ((4 + (b) * 2 + (h)) * HTB)
#define PG8_STAGE(bufoff, gbase, voff) do { _Pragma("unroll") for (int _i = 0; _i < 2; ++_i) \
        __builtin_amdgcn_global_load_lds((const unsigned*)((const char*)(gbase) + (voff)[_i]), (PG8_LAS unsigned*)(lds + (bufoff) + ldsw + _i * 8192), 16, 0, 0); } while (0)
#define PG8_LDA(dst, b, h) do { _Pragma("unroll") for (int m = 0; m < 4; ++m) _Pragma("unroll") for (int k = 0; k < 2; ++k) dst[m][k] = *(const PG8_LAS bf16x8*)(lds + PG8_SA(b, h) + aoff + m * 2048 + k * 1024); } while (0)
#define PG8_LDB(dst, b, h) do { _Pragma("unroll") for (int n = 0; n < 2; ++n) _Pragma("unroll") for (int k = 0; k < 2; ++k) dst[n][k] = *(const PG8_LAS bf16x8*)(lds + PG8_SB(b, h) + boff + n * 2048 + k * 1024); } while (0)
#define PG8_MMA(ai, bj, At, Bt) do { __builtin_amdgcn_s_setprio(1); _Pragma("unroll") for (int m = 0; m < 4; ++m) _Pragma("unroll") for (int n = 0; n < 2; ++n) _Pragma("unroll") for (int k = 0; k < 2; ++k) \
        acc[ai][bj][m][n] = __builtin_amdgcn_mfma_f32_16x16x32_bf16(Bt[n][k], At[m][k], acc[ai][bj][m][n], 0, 0, 0); __builtin_amdgcn_s_setprio(0); } while (0)
#define PG8_WAIT_V(n) asm volatile("s_waitcnt vmcnt(" #n ")" ::: "memory")
#define PG8_WAIT_L(n) asm volatile("s_waitcnt lgkmcnt(" #n ")" ::: "memory")
#define PG8_BAR __builtin_amdgcn_s_barrier()
#define PG8_SCHED __builtin_amdgcn_sched_barrier(0)
    Unit cur, nxt; int ui = 0;
    if (!S.next(0, cur)) return;
    f32x4 acc[2][2][4][2];
#pragma unroll
    for (int a = 0; a < 2; ++a)
#pragma unroll
        for (int b = 0; b < 2; ++b)
#pragma unroll
            for (int m = 0; m < 4; ++m)
#pragma unroll
                for (int n = 0; n < 2; ++n) acc[a][b][m][n] = (f32x4){0.f, 0.f, 0.f, 0.f};
    bf16x8 At[4][2], B0[2][2], B1[2][2];
    const char* cA = (const char*)g.A + (size_t)cur.pm * tstep; const char* cB = (const char*)g.Bt + (size_t)cur.pn * tstep;
    S.a_ready(cur);
    if constexpr (SP2) {
        PG8_STAGE(PG8_SB(0, 0), cB, voffB); PG8_STAGE(PG8_SB(0, 1), cB + hstep, voffB); PG8_STAGE(PG8_SA(0, 0), cA, voffA); PG8_STAGE(PG8_SA(0, 1), cA + hstep, voffA);
        if (wr == 1) PG8_BAR;
        PG8_WAIT_V(2); PG8_BAR;
        PG8_STAGE(PG8_SB(1, 0), cB + kstep, voffB); PG8_STAGE(PG8_SA(1, 0), cA + kstep, voffA); PG8_STAGE(PG8_SB(1, 1), cB + hstep + kstep, voffB);
        PG8_WAIT_V(6); PG8_BAR;
    } else {
        PG8_STAGE(PG8_SB(0, 0), cB, voffB); PG8_STAGE(PG8_SA(0, 0), cA, voffA); PG8_STAGE(PG8_SB(0, 1), cB + hstep, voffB); PG8_STAGE(PG8_SA(0, 1), cA + hstep, voffA);
        if (wr == 1) PG8_BAR;
        PG8_WAIT_V(4); PG8_BAR;
        PG8_STAGE(PG8_SB(1, 0), cB + kstep, voffB); PG8_STAGE(PG8_SA(1, 0), cA + kstep, voffA); PG8_STAGE(PG8_SB(1, 1), cB + hstep + kstep, voffB);
        PG8_WAIT_V(6); PG8_BAR;
    }
    for (;;) {
        const bool has_next = S.next(ui + 1, nxt);
        const char* nA = has_next ? (const char*)g.A + (size_t)nxt.pm * tstep : cA; const char* nB = has_next ? (const char*)g.Bt + (size_t)nxt.pn * tstep : cB;
        for (int t = 0; t < nt; t += 2) {
            const bool last = (t == nt - 2);
            const char* a1 = cA + (size_t)(t + 1) * kstep;
            const char* a2 = last ? nA : cA + (size_t)(t + 2) * kstep; const char* b2 = last ? nB : cB + (size_t)(t + 2) * kstep;
            const char* a3 = a2 + kstep; const char* b3 = b2 + kstep;
            if (last && has_next) S.a_ready(nxt);
            if constexpr (SP2) {
            PG8_LDB(B0, 0, 0); PG8_LDB(B1, 0, 1); PG8_SCHED; PG8_LDA(At, 0, 0); PG8_STAGE(PG8_SA(1, 1), a1 + hstep, voffA);
            PG8_WAIT_V(8); PG8_WAIT_L(0); PG8_BAR; PG8_MMA(0, 0, At, B0); PG8_MMA(0, 1, At, B1); PG8_BAR; PG8_SCHED;
            PG8_LDA(At, 0, 1); PG8_STAGE(PG8_SB(0, 0), b2, voffB); PG8_STAGE(PG8_SB(0, 1), b2 + hstep, voffB); PG8_STAGE(PG8_SA(0, 0), a2, voffA);
            PG8_WAIT_V(8); PG8_WAIT_L(0); PG8_BAR; PG8_MMA(1, 0, At, B0); PG8_MMA(1, 1, At, B1); PG8_BAR; PG8_SCHED;
            PG8_LDB(B0, 1, 0); PG8_LDB(B1, 1, 1); PG8_SCHED; PG8_LDA(At, 1, 0); PG8_STAGE(PG8_SA(0, 1), a2 + hstep, voffA);
            PG8_WAIT_V(8); PG8_WAIT_L(0); PG8_BAR; PG8_MMA(0, 0, At, B0); PG8_MMA(0, 1, At, B1); PG8_BAR; PG8_SCHED;
            PG8_LDA(At, 1, 1); PG8_STAGE(PG8_SB(1, 0), b3, voffB); PG8_STAGE(PG8_SB(1, 1), b3 + hstep, voffB); PG8_STAGE(PG8_SA(1, 0), a3, voffA);
            PG8_WAIT_V(8); PG8_WAIT_L(0); PG8_BAR; PG8_MMA(1, 0, At, B0); PG8_MMA(1, 1, At, B1); PG8_BAR; PG8_SCHED;
            } else {
            PG8_LDB(B0, 0, 0); PG8_SCHED; PG8_LDA(At, 0, 0); PG8_STAGE(PG8_SA(1, 1), a1 + hstep, voffA);
            PG8_WAIT_L(8); PG8_BAR; PG8_WAIT_L(0); PG8_MMA(0, 0, At, B0); PG8_BAR; PG8_SCHED;
            PG8_LDB(B1, 0, 1); PG8_STAGE(PG8_SB(0, 0), b2, voffB);
            PG8_BAR; PG8_WAIT_L(0); PG8_MMA(0, 1, At, B1); PG8_BAR;
            PG8_LDA(At, 0, 1); PG8_STAGE(PG8_SA(0, 0), a2, voffA);
            PG8_BAR; PG8_WAIT_L(0); PG8_MMA(1, 0, At, B0); PG8_BAR; PG8_SCHED;
            PG8_STAGE(PG8_SB(0, 1), b2 + hstep, voffB);
            PG8_WAIT_V(6); PG8_BAR; PG8_MMA(1, 1, At, B1); PG8_BAR;
            PG8_LDB(B0, 1, 0); PG8_SCHED; PG8_LDA(At, 1, 0); PG8_STAGE(PG8_SA(0, 1), a2 + hstep, voffA);
            PG8_WAIT_L(8); PG8_BAR; PG8_WAIT_L(0); PG8_MMA(0, 0, At, B0); PG8_BAR; PG8_SCHED;
            PG8_LDB(B1, 1, 1); PG8_STAGE(PG8_SB(1, 0), b3, voffB);
            PG8_BAR; PG8_WAIT_L(0); PG8_MMA(0, 1, At, B1); PG8_BAR;
            PG8_LDA(At, 1, 1); PG8_STAGE(PG8_SA(1, 0), a3, voffA);
            PG8_BAR; PG8_WAIT_L(0); PG8_MMA(1, 0, At, B0); PG8_BAR; PG8_SCHED;
            PG8_STAGE(PG8_SB(1, 1), b3 + hstep, voffB);
            PG8_WAIT_V(6); PG8_BAR; PG8_MMA(1, 1, At, B1); PG8_BAR;
            }
        }
        if constexpr (ALIGN_EPI) { if (wr == 0) PG8_BAR; }
        E(acc, cur, wr, wc, fr, fq); S.done(cur);
        if (!has_next) break;
#pragma unroll
        for (int a = 0; a < 2; ++a)
#pragma unroll
            for (int b = 0; b < 2; ++b)
#pragma unroll
                for (int m = 0; m < 4; ++m)
#pragma unroll
                    for (int n = 0; n < 2; ++n) acc[a][b][m][n] = (f32x4){0.f, 0.f, 0.f, 0.f};
        cur = nxt; cA = nA; cB = nB; ++ui;
        if constexpr (ALIGN_EPI) { if (wr == 1) PG8_BAR; }
    }
    PG8_WAIT_V(0);
    if constexpr (!ALIGN_EPI) { if (wr == 0) PG8_BAR; }
    PG8_BAR;
#undef PG8_SA
#undef PG8_SB
#undef PG8_STAGE
#undef PG8_LDA
#undef PG8_LDB
#undef PG8_MMA
#undef PG8_WAIT_V
#undef PG8_WAIT_L
#undef PG8_BAR
#undef PG8_SCHED
}

typedef f32x4 Acc[2][2][4][2];

struct EpiGU {
    static constexpr bool PERM = true;
    bf16_t* act0; bf16_t* act1; int split_row; const float* ss; int row_base;
    __device__ __forceinline__ void operator()(const Acc& acc, const Unit& u, int wr, int wc, int fr, int fq) const {
        const int row0 = row_base + u.pm * BM + wr * 64 + fr, col = u.pn * 128 + wc * 32 + 8 * fq;
#pragma unroll
        for (int ai = 0; ai < 2; ++ai)
#pragma unroll
            for (int m = 0; m < 4; ++m) {
                const int r = row0 + ai * HALF + m * 16;
                const float s = __builtin_amdgcn_rsqf(ss[r] * (1.f / DM) + EPS);
                bf16_t* dst = (r < split_row ? act0 + (size_t)r * DFF : act1 + (size_t)(r - split_row) * DFF) + col;
                float o[8];
#pragma unroll
                for (int n = 0; n < 2; ++n)
#pragma unroll
                    for (int i = 0; i < 4; ++i) { const float g = acc[ai][0][m][n][i] * s, up = acc[ai][1][m][n][i] * s; o[4 * n + i] = fsilu(g) * up; }
                *(u32x4*)dst = pack8(o);
            }
    }
};

template <int RES  , int OUT  >
struct EpiRes {
    static constexpr bool PERM = true;
    const float* xp; const float* xs; bf16_t* hb; float* outf; float alpha; float* ss_out; int row_base;
    __device__ __forceinline__ void operator()(const Acc& acc, const Unit& u, int wr, int wc, int fr, int fq) const {
        const int row0 = row_base + u.pm * BM + wr * 64 + fr, col0 = u.pn * BM + wc * 32 + 8 * fq;
#pragma unroll
        for (int ai = 0; ai < 2; ++ai)
#pragma unroll
            for (int m = 0; m < 4; ++m) {
                const int r = row0 + ai * HALF + m * 16; float sq = 0.f;
#pragma unroll
                for (int bj = 0; bj < 2; ++bj) {
                    const int c = col0 + bj * HALF; float res[8], v[8];
                    if (RES == 0) { const float* xr = (r < NP_ROWS ? xp + (size_t)r * DM : xs + (size_t)(r - NP_ROWS) * DM) + c; const f32x4 a = *(const f32x4*)xr, b = *(const f32x4*)(xr + 4);
                        res[0] = a[0]; res[1] = a[1]; res[2] = a[2]; res[3] = a[3]; res[4] = b[0]; res[5] = b[1]; res[6] = b[2]; res[7] = b[3]; }
                    else { const u32x4 w = *(const u32x4*)(hb + (size_t)r * DM + c); unpack8(w, res); }
#pragma unroll
                    for (int n = 0; n < 2; ++n)
#pragma unroll
                        for (int i = 0; i < 4; ++i) { const float t = res[4 * n + i] + alpha * acc[ai][bj][m][n][i]; v[4 * n + i] = t; sq += t * t; }
                    if (OUT == 0) *(u32x4*)(hb + (size_t)r * DM + c) = pack8(v);
                    else { float* o = outf + (size_t)r * DM + c; *(f32x4*)o = (f32x4){v[0], v[1], v[2], v[3]}; *(f32x4*)(o + 4) = (f32x4){v[4], v[5], v[6], v[7]}; }
                }
                sq += __shfl_xor(sq, 16); sq += __shfl_xor(sq, 32);
                if (fq == 0) atomicAdd(ss_out + r, sq);
            }
    }
};

struct EpiPre {
    static constexpr bool PERM = true;
    bf16_t* xbc; bf16_t* q; bf16_t* logf; bf16_t* v; const float* ss; const float* lbv; int grow0;
    __device__ __forceinline__ void operator()(const Acc& acc, const Unit& u, int wr, int wc, int fr, int fq) const {
        const int row0 = u.pm * BM + wr * 64 + fr, pn = u.pn;
        int mode, ld, cb; bf16_t* base;
        if (pn < 8) { mode = 0; base = xbc; ld = 2048; cb = pn * 256; }
        else if (pn < 12) { mode = 1; base = q; ld = 1024; cb = (pn - 8) * 256; }
        else if (pn < 20) { mode = 2; base = logf; ld = 2048; cb = (pn - 12) * 256; }
        else { mode = 0; base = v; ld = 1024; cb = (pn - 20) * 256; }
        const int col0 = cb + wc * 32 + 8 * fq;
#pragma unroll
        for (int ai = 0; ai < 2; ++ai)
#pragma unroll
            for (int m = 0; m < 4; ++m) {
                const int r = row0 + ai * HALF + m * 16;
                const float s = __builtin_amdgcn_rsqf(ss[grow0 + r] * (1.f / DM) + EPS);
#pragma unroll
                for (int bj = 0; bj < 2; ++bj) {
                    const int c = col0 + bj * HALF; float o[8];
#pragma unroll
                    for (int n = 0; n < 2; ++n)
#pragma unroll
                        for (int i = 0; i < 4; ++i) o[4 * n + i] = acc[ai][bj][m][n][i] * s;
                    u32x4 w;
                    if (mode == 0) w = pack8(o);
                    else if (mode == 1) {
#pragma unroll
                        for (int i = 0; i < 8; ++i) o[i] = fsilu(o[i]);
                        w = pack8(o);
                    } else {
                        const f32x4 l0 = *(const f32x4*)(lbv + c), l1 = *(const f32x4*)(lbv + c + 4);
                        const float lb[8] = {l0[0], l0[1], l0[2], l0[3], l1[0], l1[1], l1[2], l1[3]};
#pragma unroll
                        for (int i = 0; i < 8; ++i) { const float f = lb[i] + (1.f - lb[i]) * fsigmoid(o[i]); o[i] = __logf(f); }
                        w.x = pkh2(o[0], o[1]); w.y = pkh2(o[2], o[3]); w.z = pkh2(o[4], o[5]); w.w = pkh2(o[6], o[7]);
                    }
                    *(u32x4*)(base + (size_t)r * ld + c) = w;
                }
            }
    }
};

struct EpiPost {
    static constexpr bool PERM = true;
    bf16_t* out; const float* ss; int grow0; int gmode;
    __device__ __forceinline__ void operator()(const Acc& acc, const Unit& u, int wr, int wc, int fr, int fq) const {
        const int row0 = u.pm * BM + wr * 64 + fr, col0 = u.pn * 256 + wc * 32 + 8 * fq;
#pragma unroll
        for (int ai = 0; ai < 2; ++ai)
#pragma unroll
            for (int m = 0; m < 4; ++m) {
                const int r = row0 + ai * HALF + m * 16;
                const float s = __builtin_amdgcn_rsqf(ss[grow0 + r] * (1.f / DM) + EPS);
#pragma unroll
                for (int bj = 0; bj < 2; ++bj) {
                    const int c = col0 + bj * HALF; float o[8];
#pragma unroll
                    for (int n = 0; n < 2; ++n)
#pragma unroll
                        for (int i = 0; i < 4; ++i) { const float t = acc[ai][bj][m][n][i] * s; o[4 * n + i] = gmode ? fsigmoid(t) : fsilu(t); }
                    *(u32x4*)(out + (size_t)r * 2048 + c) = pack8(o);
                }
            }
    }
};

template <int FIRST>
struct EpiMerge {
    static constexpr bool PERM = true;
    bf16_t* merged; const bf16_t* gates; int rbase;
    __device__ __forceinline__ void operator()(const Acc& acc, const Unit& u, int wr, int wc, int fr, int fq) const {
        const int row0 = rbase + u.pm * BM + wr * 64 + fr, col0 = u.pn * BM + wc * 32 + 8 * fq;
#pragma unroll
        for (int ai = 0; ai < 2; ++ai)
#pragma unroll
            for (int m = 0; m < 4; ++m) {
                const int r = row0 + ai * HALF + m * 16;
#pragma unroll
                for (int bj = 0; bj < 2; ++bj) {
                    const int c = col0 + bj * HALF; float gt[8], o[8];
                    unpack8(*(const u32x4*)(gates + (size_t)r * 2048 + (FIRST ? 0 : 1024) + c), gt);
                    if (FIRST) {
#pragma unroll
                        for (int i = 0; i < 8; ++i) o[i] = 0.f;
                    } else unpack8(*(const u32x4*)(merged + (size_t)r * DM + c), o);
#pragma unroll
                    for (int n = 0; n < 2; ++n)
#pragma unroll
                        for (int i = 0; i < 4; ++i) o[4 * n + i] += gt[4 * n + i] * acc[ai][bj][m][n][i];
                    *(u32x4*)(merged + (size_t)r * DM + c) = pack8(o);
                }
            }
    }
};
}

__device__ __forceinline__ f32x4 sg16(const bf16_t* A, int lda, const bf16_t* Bt, int K, int lane) {
    const int r = lane & 15, q = lane >> 4;
    const bf16_t* ap = A + (size_t)r * lda + q * 8; const bf16_t* bp = Bt + (size_t)r * K + q * 8;
    f32x4 acc = {0.f, 0.f, 0.f, 0.f};
    for (int k = 0; k < K; k += 256) {
        bf16x8 a[8], b[8];
#pragma unroll
        for (int u = 0; u < 8; ++u) { a[u] = *(const bf16x8*)(ap + k + 32 * u); b[u] = *(const bf16x8*)(bp + k + 32 * u); }
#pragma unroll
        for (int u = 0; u < 8; ++u) acc = __builtin_amdgcn_mfma_f32_16x16x32_bf16(a[u], b[u], acc, 0, 0, 0);
    }
    return acc;
}

__device__ __forceinline__ void tr_item(const float* W, int N, int K, int n0, int k0, bf16_t* WT, int drow, const float* scale, LAS float* scr, int lane) {
#pragma unroll 8
    for (int i = 0; i < 32; ++i) { const int kk = 2 * i + (lane >> 5); float v = W[(size_t)(k0 + kk) * N + n0 + (lane & 31)]; if (scale) v *= scale[k0 + kk]; scr[kk * 33 + (lane & 31)] = v; }
    asm volatile("s_waitcnt lgkmcnt(0)" ::: "memory");
    const int c = lane & 7;
#pragma unroll
    for (int j = 0; j < 4; ++j) { const int n = (lane >> 3) + 8 * j; const LAS float* s = scr + (8 * c) * 33 + n;
        u32x4 o; o.x = pk2(s[0 * 33], s[1 * 33]); o.y = pk2(s[2 * 33], s[3 * 33]); o.z = pk2(s[4 * 33], s[5 * 33]); o.w = pk2(s[6 * 33], s[7 * 33]);
        *(u32x4*)(WT + (size_t)(drow + n) * K + k0 + 8 * c) = o; }
    asm volatile("s_waitcnt lgkmcnt(0)" ::: "memory");
}
__device__ __forceinline__ void tr_job(const float* W, int N, int K, int c0, int nc, bf16_t* WT, int d0, int mode, const float* scale, LAS float* scr, int gw, int ngw, int lane) {
    const int nblk = nc / 32, nitems = (K / 64) * nblk;
    for (int it = gw; it < nitems; it += ngw) {
        const int kb = it / nblk, nb = it % nblk, n0 = 32 * nb; int drow;
        if (mode == 0) drow = d0 + n0;
        else { const int j = n0 < DFF ? n0 : n0 - DFF; drow = (j / 128) * 256 + (j % 128) + (n0 < DFF ? 0 : 128); }
        tr_item(W, N, K, c0 + n0, 64 * kb, WT, drow, scale, scr, lane);
    }
}

constexpr int B_X1 = 0, B_X2 = 17408, B_VA = 35840, B_VB = 46080, B_ACS = 56320, B_R = 56576, B_C1 = 56832, B_C2 = 57344, B_E = 57856, BUFSZ = 58368;
constexpr int L_M = 2 * BUFSZ, L_S = L_M + 9216, L_OUT = L_S + 17408, SCAN_LDS_END = L_OUT + 9216;
constexpr int P136 = 136, P144 = 144, P80 = 80, P72 = 72;
typedef short v4i16_t __attribute__((ext_vector_type(4)));

#define LDF(base, row, col, pitch) (*(const LAS bf16x8*)(lds + (base) + ((row) * (pitch) + (col)) * 2))
__device__ __forceinline__ bf16x8 trfrag(LAS unsigned char* lds, int base, int pitch, int c, int ks, int lane) {
    const int g = lane >> 4, q = (lane & 15) >> 2, p = lane & 3;
    const int off = base + ((32 * ks + 8 * g + q) * pitch + 16 * c + 4 * p) * 2;
    const v4i16_t v0 = __builtin_amdgcn_ds_read_tr16_b64_v4i16((LAS v4i16_t*)(lds + off));
    const v4i16_t v1 = __builtin_amdgcn_ds_read_tr16_b64_v4i16((LAS v4i16_t*)(lds + off + 8 * pitch));
    return __builtin_shufflevector(v0, v1, 0, 1, 2, 3, 4, 5, 6, 7);
}

struct ScanItem {
    int kind;
    int head, dir, vh, nC;
    int row0;
    int grow0;
    const bf16_t* xc; const bf16_t* xcm; const float* dt; const float* dtm; float Aneg;
    const bf16_t* q; const bf16_t* logf; const bf16_t* v; const bf16_t* logfm; const bf16_t* vm; const float* hsc;
    bf16_t* out;
    int ocol;
};

template <int KIND>
__device__ __forceinline__ void scan_run(LAS unsigned char* lds, const ScanItem& it) {
    const int tid = fresh_tid(), lane = tid & 63, wv = __builtin_amdgcn_readfirstlane(tid >> 6), fr = lane & 15, fq = lane >> 4;
    const int nSteps = it.nC + (it.dir == 0 ? 1 : 0);
    const int tr = wv >> 1, tc0 = (wv & 1) * 2, nt0 = (wv & 1) * 4;
    const int r0 = tid >> 4, ch = tid & 15, rxr = tid >> 3, xch = tid & 7;
    f32x4 S[4];
#pragma unroll
    for (int i = 0; i < 4; ++i) S[i] = (f32x4){0.f, 0.f, 0.f, 0.f};
    u32x4 ra[2], rb[2], rx; float dtv = 0.f, sc1 = 0.f, sc2 = 0.f, sce = 0.f;
    const u32x4 Z4 = {0u, 0u, 0u, 0u};

#define SCAN_LOAD(st) do { \
        const bool meta = (it.dir == 0 && (st) == 0); \
        const int c = it.dir == 0 ? (st) - 1 : it.nC - 1 - (st); \
        if (meta) { \
            if (KIND == 0) { const int cb = (it.head >> 2) * 128 + 8 * ch; \
                ra[0] = Z4; rb[0] = Z4; rx = Z4; ra[1] = Z4; rb[1] = Z4; dtv = 0.f; \
                if (r0 < 16) { ra[0] = *(const u32x4*)(it.xcm + (size_t)r0 * 2048 + 1536 + cb); rb[0] = *(const u32x4*)(it.xcm + (size_t)r0 * 2048 + 1024 + cb); } \
                if (rxr < 16) rx = *(const u32x4*)(it.xcm + (size_t)rxr * 2048 + it.head * 64 + 8 * xch); \
                if (lane < 16) dtv = it.dtm[lane * 32 + it.head]; } \
            else { ra[0] = Z4; ra[1] = Z4; rb[0] = Z4; rb[1] = Z4; rx = Z4; \
                if (lane < 16) { rb[0] = *(const u32x4*)(it.logfm + (size_t)lane * 2048 + it.head * 128 + 8 * wv); rb[1] = *(const u32x4*)(it.logfm + (size_t)lane * 2048 + it.head * 128 + 8 * (wv + 8)); \
                    rx = *(const u32x4*)(it.vm + (size_t)lane * 1024 + it.head * 128 + it.vh * 64 + 8 * wv); } } \
        } else { \
            const size_t g0 = (size_t)(it.row0 + 64 * c + (it.dir == 0 ? r0 : 63 - r0)), g1 = (size_t)(it.row0 + 64 * c + (it.dir == 0 ? r0 + 32 : 31 - r0)), gx = (size_t)(it.row0 + 64 * c + (it.dir == 0 ? rxr : 63 - rxr)); \
            if (KIND == 0) { const int cb = (it.head >> 2) * 128 + 8 * ch; \
                ra[0] = *(const u32x4*)(it.xc + g0 * 2048 + 1536 + cb); ra[1] = *(const u32x4*)(it.xc + g1 * 2048 + 1536 + cb); \
                rb[0] = *(const u32x4*)(it.xc + g0 * 2048 + 1024 + cb); rb[1] = *(const u32x4*)(it.xc + g1 * 2048 + 1024 + cb); \
                rx = *(const u32x4*)(it.xc + gx * 2048 + it.head * 64 + 8 * xch); \
                dtv = it.dt[(size_t)(it.grow0 + 64 * c + (it.dir == 0 ? lane : 63 - lane)) * 32 + it.dir * 16 + it.head]; } \
            else { const int cq = it.head * 128 + 8 * ch; \
                ra[0] = *(const u32x4*)(it.q + g0 * 1024 + cq); ra[1] = *(const u32x4*)(it.q + g1 * 1024 + cq); \
                rb[0] = *(const u32x4*)(it.logf + g0 * 2048 + it.dir * 1024 + cq); rb[1] = *(const u32x4*)(it.logf + g1 * 2048 + it.dir * 1024 + cq); \
                rx = *(const u32x4*)(it.v + gx * 1024 + it.head * 128 + it.vh * 64 + 8 * xch); \
                if (tid < 128) { const float* hp = it.hsc + (size_t)(it.row0 / 64 + c) * 6144 + it.dir * 1024 + it.head * 128 + tid; sc1 = hp[0]; sc2 = hp[2048]; sce = hp[4096]; } } \
        } } while (0)

#define SCAN_PREP(bo) do { \
        if (KIND == 0) { \
            const float a_ = dtv * it.Aneg; const float acs = wave_scan(a_, lane); const float aend = lane_bcast(acs, 63); \
            *(LAS u32x4*)(lds + (bo) + B_X1 + (r0 * P136 + 8 * ch) * 2) = ra[0]; *(LAS u32x4*)(lds + (bo) + B_X1 + ((r0 + 32) * P136 + 8 * ch) * 2) = ra[1]; \
            *(LAS u32x4*)(lds + (bo) + B_X2 + (r0 * P144 + 8 * ch) * 2) = rb[0]; *(LAS u32x4*)(lds + (bo) + B_X2 + ((r0 + 32) * P144 + 8 * ch) * 2) = rb[1]; \
            const int srcl = 8 * wv + (lane >> 3); \
            const float dtr = __shfl(dtv, srcl), acr = __shfl(acs, srcl), dte = __expf(aend - acr); \
            float x_[8], xe_[8]; unpack8(rx, x_); \
            _Pragma("unroll") for (int e = 0; e < 8; ++e) { x_[e] *= dtr; xe_[e] = x_[e] * dte; } \
            *(LAS u32x4*)(lds + (bo) + B_VA + (rxr * P80 + 8 * xch) * 2) = pack8(x_); \
            *(LAS u32x4*)(lds + (bo) + B_VB + (rxr * P80 + 8 * xch) * 2) = pack8(xe_); \
            if (wv == 0) { *(LAS float*)(lds + (bo) + B_ACS + lane * 4) = acs; *(LAS float*)(lds + (bo) + B_R + lane * 4) = __expf(acs); } \
            if (wv == 1 || wv == 2) { const int n_ = (wv - 1) * 64 + lane; *(LAS float*)(lds + (bo) + B_C1 + n_ * 4) = __expf(aend); *(LAS float*)(lds + (bo) + B_C2 + n_ * 4) = 1.f; *(LAS float*)(lds + (bo) + B_E + n_ * 4) = 1.f; } \
        } else { \
            *(LAS u32x4*)(lds + (bo) + B_X1 + (r0 * P136 + 8 * ch) * 2) = ra[0]; *(LAS u32x4*)(lds + (bo) + B_X1 + ((r0 + 32) * P136 + 8 * ch) * 2) = ra[1]; \
            *(LAS u32x4*)(lds + (bo) + B_X2 + (r0 * P144 + 8 * ch) * 2) = rb[0]; *(LAS u32x4*)(lds + (bo) + B_X2 + ((r0 + 32) * P144 + 8 * ch) * 2) = rb[1]; \
            *(LAS u32x4*)(lds + (bo) + B_VA + (rxr * P80 + 8 * xch) * 2) = rx; \
            if (tid < 128) { *(LAS float*)(lds + (bo) + B_C1 + tid * 4) = sc1; *(LAS float*)(lds + (bo) + B_C2 + tid * 4) = sc2; *(LAS float*)(lds + (bo) + B_E + tid * 4) = sce; } \
        } } while (0)

    bool pend = false; int pc = 0;
#define SCAN_FLUSH() do { if (pend) { const int _r = tid >> 3, _sg = tid & 7; const u32x4 _v = *(const LAS u32x4*)(lds + L_OUT + (_r * P72 + 8 * _sg) * 2); \
        const int _lr = it.dir == 0 ? _r : 63 - _r; *(u32x4*)(it.out + (size_t)(it.row0 + 64 * pc + _lr) * 1024 + it.ocol + 8 * _sg) = _v; } } while (0)

    SCAN_LOAD(0);
    if (KIND == 1 && it.dir == 0) {
#pragma unroll
        for (int i = 0; i < 2; ++i) { const int cv = wv + 8 * i;
            float lf[8], ke[8];
            lf[0] = hlo(rb[i].x); lf[1] = hhi(rb[i].x); lf[2] = hlo(rb[i].y); lf[3] = hhi(rb[i].y); lf[4] = hlo(rb[i].z); lf[5] = hhi(rb[i].z); lf[6] = hlo(rb[i].w); lf[7] = hhi(rb[i].w);
#pragma unroll
            for (int e = 0; e < 8; ++e) {
                const float b = wave_scan(lf[e], lane); const float ref = lane_bcast(b, 31), tot = lane_bcast(b, 63);
                ke[e] = (1.f - __expf(lf[e])) * __expf(ref - b);
                if (lane == 0) { *(LAS float*)(lds + B_C1 + (8 * cv + e) * 4) = __expf(tot); *(LAS float*)(lds + B_C2 + (8 * cv + e) * 4) = __expf(tot - ref); *(LAS float*)(lds + B_E + (8 * cv + e) * 4) = __expf(ref); }
            }
            *(LAS u32x4*)(lds + B_X1 + (lane * P136 + 8 * cv) * 2) = Z4;
            *(LAS u32x4*)(lds + B_X2 + (lane * P144 + 8 * cv) * 2) = pack8(ke);
        }
        *(LAS u32x4*)(lds + B_VA + (lane * P80 + 8 * wv) * 2) = rx;
    } else SCAN_PREP(0);
    if (nSteps > 1) SCAN_LOAD(1);

    for (int st = 0; st < nSteps; ++st) {
        const int bo = (st & 1) * BUFSZ;
        const bool do_out = !(it.dir == 0 && st == 0);
        __syncthreads();
#pragma unroll
        for (int i = 0; i < 4; ++i) { const int n = 16 * (nt0 + i) + fr; const float e = *(const LAS float*)(lds + bo + B_E + n * 4);
#pragma unroll
            for (int j = 0; j < 4; j += 2) { const unsigned w = pk2(S[i][j] * e, S[i][j + 1] * e);
                *(LAS bf16_t*)(lds + L_S + ((16 * tr + 4 * fq + j) * P136 + n) * 2) = (bf16_t)(w & 0xffffu); *(LAS bf16_t*)(lds + L_S + ((16 * tr + 4 * fq + j + 1) * P136 + n) * 2) = (bf16_t)(w >> 16); } }
        bf16x8 xa[4];
        if (do_out) {
            f32x4 g0 = {0.f, 0.f, 0.f, 0.f}, g1 = {0.f, 0.f, 0.f, 0.f};
#pragma unroll
            for (int kk = 0; kk < 4; ++kk) { xa[kk] = LDF(bo + B_X1, 16 * tr + fr, 32 * kk + 8 * fq, P136); const bf16x8 b0 = LDF(bo + B_X2, 16 * tc0 + fr, 32 * kk + 8 * fq, P144), b1 = LDF(bo + B_X2, 16 * (tc0 + 1) + fr, 32 * kk + 8 * fq, P144);
                g0 = __builtin_amdgcn_mfma_f32_16x16x32_bf16(xa[kk], b0, g0, 0, 0, 0); g1 = __builtin_amdgcn_mfma_f32_16x16x32_bf16(xa[kk], b1, g1, 0, 0, 0); }
#pragma unroll
            for (int h = 0; h < 2; ++h) { const int s = 16 * (tc0 + h) + fr; float as = 0.f; if (KIND == 0) as = *(const LAS float*)(lds + bo + B_ACS + s * 4);
                float gm[4];
#pragma unroll
                for (int j = 0; j < 4; ++j) { const int t = 16 * tr + 4 * fq + j; float g = h ? g1[j] : g0[j];
                    if (KIND == 0) { const float at = *(const LAS float*)(lds + bo + B_ACS + t * 4); g *= __expf(fminf(at - as, 0.f)); }
                    gm[j] = (s <= t) ? g : 0.f; }
#pragma unroll
                for (int j = 0; j < 4; j += 2) { const int t = 16 * tr + 4 * fq + j; const unsigned w = pk2(gm[j], gm[j + 1]);
                    *(LAS bf16_t*)(lds + L_M + (t * P72 + s) * 2) = (bf16_t)(w & 0xffffu); *(LAS bf16_t*)(lds + L_M + ((t + 1) * P72 + s) * 2) = (bf16_t)(w >> 16); } }
        }
        SCAN_FLUSH();
        __syncthreads();
        if (do_out) {
            f32x4 z0 = {0.f, 0.f, 0.f, 0.f}, z1 = {0.f, 0.f, 0.f, 0.f};
#pragma unroll
            for (int kk = 0; kk < 4; ++kk) { const bf16x8 b0 = LDF(L_S, 16 * tc0 + fr, 32 * kk + 8 * fq, P136), b1 = LDF(L_S, 16 * (tc0 + 1) + fr, 32 * kk + 8 * fq, P136);
                z0 = __builtin_amdgcn_mfma_f32_16x16x32_bf16(xa[kk], b0, z0, 0, 0, 0); z1 = __builtin_amdgcn_mfma_f32_16x16x32_bf16(xa[kk], b1, z1, 0, 0, 0); }
            if (KIND == 0) {
#pragma unroll
                for (int j = 0; j < 4; ++j) { const float r = *(const LAS float*)(lds + bo + B_R + (16 * tr + 4 * fq + j) * 4); z0[j] *= r; z1[j] *= r; } }
#pragma unroll
            for (int kk = 0; kk < 2; ++kk) { const bf16x8 a = LDF(L_M, 16 * tr + fr, 32 * kk + 8 * fq, P72), b0 = trfrag(lds, bo + B_VA, P80, tc0, kk, lane), b1 = trfrag(lds, bo + B_VA, P80, tc0 + 1, kk, lane);
                z0 = __builtin_amdgcn_mfma_f32_16x16x32_bf16(a, b0, z0, 0, 0, 0); z1 = __builtin_amdgcn_mfma_f32_16x16x32_bf16(a, b1, z1, 0, 0, 0); }
#pragma unroll
            for (int j = 0; j < 4; ++j) { const int t = 16 * tr + 4 * fq + j; const unsigned w = pk2(z0[j], z1[j]);
                *(LAS bf16_t*)(lds + L_OUT + (t * P72 + 16 * tc0 + fr) * 2) = (bf16_t)(w & 0xffffu); *(LAS bf16_t*)(lds + L_OUT + (t * P72 + 16 * (tc0 + 1) + fr) * 2) = (bf16_t)(w >> 16); }
        }
        pend = do_out; pc = it.dir == 0 ? st - 1 : it.nC - 1 - st;
        {
            f32x4 d[4];
#pragma unroll
            for (int i = 0; i < 4; ++i) d[i] = (f32x4){0.f, 0.f, 0.f, 0.f};
#pragma unroll
            for (int kk = 0; kk < 2; ++kk) { const bf16x8 a = trfrag(lds, bo + (KIND == 0 ? B_VB : B_VA), P80, tr, kk, lane);
#pragma unroll
                for (int i = 0; i < 4; ++i) { const bf16x8 b = trfrag(lds, bo + B_X2, P144, nt0 + i, kk, lane); d[i] = __builtin_amdgcn_mfma_f32_16x16x32_bf16(a, b, d[i], 0, 0, 0); } }
#pragma unroll
            for (int i = 0; i < 4; ++i) { const int n = 16 * (nt0 + i) + fr; const float c1 = *(const LAS float*)(lds + bo + B_C1 + n * 4), c2 = *(const LAS float*)(lds + bo + B_C2 + n * 4);
#pragma unroll
                for (int j = 0; j < 4; ++j) S[i][j] = c1 * S[i][j] + c2 * d[i][j]; }
        }
        if (st + 1 < nSteps) { SCAN_PREP(BUFSZ - bo); if (st + 2 < nSteps) SCAN_LOAD(st + 2); }
    }
    __syncthreads();
    SCAN_FLUSH();
    __syncthreads();
#undef SCAN_FLUSH
#undef SCAN_PREP
#undef SCAN_LOAD
}

#define XB_TMO      128
#define XB_XCNT(j)  (256  + 64 * (j))
#define XB_XSUB(j)  (1280 + 64 * (j))
#define XB_XGEN(j)  (2304 + 64 * (j))
#define XB_TOP      3328
#define XB_TOPGEN   3392
#define XCD_BAR_WORDS 3456
#define XB_SPIN_CAP (1u << 22)
__device__ __forceinline__ unsigned xb_ld(unsigned* p)              { return __hip_atomic_load(p, __ATOMIC_RELAXED, __HIP_MEMORY_SCOPE_AGENT); }
__device__ __forceinline__ unsigned xb_add(unsigned* p, unsigned v) { return __hip_atomic_fetch_add(p, v, __ATOMIC_RELAXED, __HIP_MEMORY_SCOPE_AGENT); }
__device__ __forceinline__ unsigned xb_xcc_id() { return (unsigned)__builtin_amdgcn_s_getreg((3 << 11) | 20) & 0xFu; }
#define XB_SPIN(cond, bar) do { unsigned _sp = 0; while (cond) { __builtin_amdgcn_s_sleep(1); \
    if ((++_sp & 255u) == 0u) { if (xb_ld(&(bar)[XB_TMO])) break; if (_sp > XB_SPIN_CAP) { atomicAdd(&(bar)[XB_TMO], 1u); break; } } } } while (0)
struct XcdBarrier { unsigned* bar; unsigned x; volatile LAS unsigned* st; };
__device__ __forceinline__ XcdBarrier xcd_barrier_post(unsigned* bar, volatile LAS unsigned* st) {
    XcdBarrier b; b.bar = bar; b.x = xb_xcc_id(); b.st = st;
    if (threadIdx.x == 0) (void)xb_add(&bar[XB_XCNT(b.x)], 1u);
    return b;
}
__device__ __forceinline__ void xcd_barrier_complete(unsigned* bar, unsigned x, unsigned& nloc, unsigned& nx) {
    const unsigned G = gridDim.x * gridDim.y * gridDim.z;
    unsigned sum, cnt, mine, sp = 0u;
    for (;;) {
        sum = 0u; cnt = 0u; mine = 0u;
#pragma unroll
        for (unsigned j = 0; j < 16; ++j) { const unsigned c = xb_ld(&bar[XB_XCNT(j)]); sum += c; cnt += (c > 0u) ? 1u : 0u; mine = (j == x) ? c : mine; }
        if (sum == G) break;
        __builtin_amdgcn_s_sleep(1);
        if ((++sp & 255u) == 0u) { if (xb_ld(&bar[XB_TMO])) break; if (sp > XB_SPIN_CAP) { atomicAdd(&bar[XB_TMO], 1u); break; } }
    }
    nloc = mine > 0u ? mine : 1u; nx = cnt > 0u ? cnt : 1u;
}
__device__ __forceinline__ void xcd_barrier(const XcdBarrier& b) {
    asm volatile("s_waitcnt vmcnt(0)" ::: "memory");
    __syncthreads();
    if (threadIdx.x == 0) {
        unsigned* bar = b.bar;
        __builtin_amdgcn_s_waitcnt(0);
        unsigned nloc = b.st[0], nx = b.st[1];
        if (nloc == 0u) { xcd_barrier_complete(bar, b.x, nloc, nx); b.st[0] = nloc; b.st[1] = nx; }
        const unsigned old = xb_add(&bar[XB_XSUB(b.x)], 1u);
        const unsigned gen = old / nloc;
        if (old + 1u == (gen + 1u) * nloc) {
            __builtin_amdgcn_fence(__ATOMIC_RELEASE, "agent");
            asm volatile("s_waitcnt vmcnt(0)" ::: "memory");
            const unsigned og = xb_add(&bar[XB_TOP], 1u);
            const unsigned tg = og / nx;
            if (og + 1u == (tg + 1u) * nx) xb_add(&bar[XB_TOPGEN], 1u);
            else XB_SPIN(xb_ld(&bar[XB_TOPGEN]) == tg, bar);
            __builtin_amdgcn_fence(__ATOMIC_ACQUIRE, "agent");
            xb_add(&bar[XB_XGEN(b.x)], 1u);
            asm volatile("s_waitcnt vmcnt(0)" ::: "memory");
        } else {
            XB_SPIN(xb_ld(&bar[XB_XGEN(b.x)]) == gen, bar);
            __builtin_amdgcn_fence(__ATOMIC_ACQUIRE, "agent");
            asm volatile("s_waitcnt vmcnt(0)" ::: "memory");
        }
    }
    __syncthreads();
}

struct Params { const float* in[23]; float* out; unsigned char* ws; };

constexpr int LDS_BST = 152576;
constexpr int LDS_BYTES = 152832;

__global__ void __launch_bounds__(512, 2) fwd_mega(Params P) {
    extern __shared__ __attribute__((aligned(16))) unsigned char lds_raw[];
    LAS unsigned char* lds = (LAS unsigned char*)lds_raw;
    cg::grid_group grid = cg::this_grid();
    const int G = gridDim.x, bx = blockIdx.x;
#define WSD unsigned char* ws = P.ws; asm volatile("" : "+s"(ws)); unsigned char* dob = (unsigned char*)P.out; asm volatile("" : "+s"(dob)); (void)dob
    volatile LAS unsigned* bst = (volatile LAS unsigned*)(lds + LDS_BST);
    if (threadIdx.x < 2) bst[threadIdx.x] = 0u;
    __syncthreads();
    (void)xcd_barrier_post((unsigned*)(P.ws + WS_BAR), bst);
#define GSYNC do { XcdBarrier _xb; _xb.bar = (unsigned*)(P.ws + WS_BAR); _xb.x = xb_xcc_id(); _xb.st = (volatile LAS unsigned*)(lds + LDS_BST); xcd_barrier(_xb); } while (0)
#define IDS WSD; const int tid = fresh_tid(), lane = tid & 63, wave = __builtin_amdgcn_readfirstlane(tid >> 6), gw = bx * 8 + wave, NGW = G * 8, gt = bx * 512 + tid, NGT = G * 512; (void)lane; (void)gw; (void)NGW; (void)gt; (void)NGT
#define x_p (P.in[0])
#define x_s (P.in[1])
#define meta (P.in[2])
#define SS0 ((float*)(ws + WS_SS0))
#define SS1 ((float*)(ws + WS_SS1))
#define SS2 ((float*)(ws + WS_SS2))
#define SS3 ((float*)(ws + WS_SS3))
#define SSM0 ((float*)(ws + WS_SSM0))
#define SSM1 ((float*)(ws + WS_SSM1))
#define LBV ((float*)(ws + WS_LBV))
#define HBM ((bf16_t*)(ws + M_HBM))
#define ACTM ((bf16_t*)(ws + M_ACTM))
#define XBCM ((bf16_t*)(ws + M_XBCM))
#define QM ((bf16_t*)(ws + M_QM))
#define LOGFM ((bf16_t*)(ws + M_LOGFM))
#define VM ((bf16_t*)(ws + M_VM))
#define DTM ((float*)(ws + M_DTM))
#define XCM ((bf16_t*)(ws + M_XCM))
#define DT ((float*)(ws + WS_DT))
#define WGU1 ((bf16_t*)(ws + WS_WGU1))
#define WD1 ((bf16_t*)(ws + WS_WD1))
#define WGU2 ((bf16_t*)(ws + WS_WGU2))
#define WD2 ((bf16_t*)(ws + WS_WD2))
#define WPRE ((bf16_t*)(ws + WS_WPRE))
#define WPOST ((bf16_t*)(ws + WS_WPOST))
#define WA ((bf16_t*)(ws + WS_WA))
#define WB ((bf16_t*)(ws + WS_WB))
#define WOUT ((bf16_t*)(ws + WS_WOUT))
#define WDT ((bf16_t*)(ws + WS_WDT))
#define HB ((bf16_t*)(ws + WS_HB))
#define ACT0 ((bf16_t*)(ws + WS_F))
#define ACT1 ((bf16_t*)dob)
#define QB ((bf16_t*)(ws + WS_QB))
#define VB ((bf16_t*)(ws + WS_VB))
#define ZG ((bf16_t*)(ws + WS_ZG))
#define GATES ((bf16_t*)(ws + WS_GATES))
#define SA QB
#define SB VB
#define XBC ((bf16_t*)(dob + DO_Y))
#define YF ((bf16_t*)(dob + DO_Y))
#define YB ((bf16_t*)(dob + DO_Y + 16 * MiB))
#define XC ((bf16_t*)(dob + DO_XC))
#define LOGF ((bf16_t*)(dob + DO_LOGF))
#define PARK GATES
#define GATES2 ((bf16_t*)(dob))
#define MERGED2 ((bf16_t*)(dob + 64 * MiB))
#define OF ((bf16_t*)(dob + DO_OF))
#define OB ((bf16_t*)(dob + DO_OB))
#define QE1 ((bf16_t*)(ws + WS_QE1))
#define HSC ((float*)(ws + WS_HSC))

    {
        IDS;
        LAS float* scr = (LAS float*)(lds + wave * 16384);
        tr_job(P.in[4], 2 * DFF, DM, 0, 2 * DFF, WGU1, 0, 1, P.in[3], scr, gw, NGW, lane);
        tr_job(P.in[5], DM, DFF, 0, DM, WD1, 0, 0, nullptr, scr, gw, NGW, lane);
        tr_job(P.in[7], IN_COLS, DM, 1024, 2048, WPRE, 0, 0, P.in[6], scr, gw, NGW, lane);
        tr_job(P.in[7], IN_COLS, DM, 3104, 1024, WPRE, 2048, 0, P.in[6], scr, gw, NGW, lane);
        tr_job(P.in[7], IN_COLS, DM, 4128, 2048, WPRE, 3072, 0, P.in[6], scr, gw, NGW, lane);
        tr_job(P.in[7], IN_COLS, DM, 6176, 1024, WPRE, 5120, 0, P.in[6], scr, gw, NGW, lane);
        tr_job(P.in[7], IN_COLS, DM, 3072, 32, WDT, 0, 0, P.in[6], scr, gw, NGW, lane);
        tr_job(P.in[7], IN_COLS, DM, 0, 1024, WPOST, 0, 0, P.in[6], scr, gw, NGW, lane);
        tr_job(P.in[7], IN_COLS, DM, 7200, 1024, WPOST, 1024, 0, P.in[6], scr, gw, NGW, lane);
        tr_job(P.in[7], IN_COLS, DM, 8224, 2048, WPOST, 2048, 0, P.in[6], scr, gw, NGW, lane);
        tr_job(P.in[14], DM, DM, 0, DM, WA, 0, 0, P.in[13], scr, gw, NGW, lane);
        tr_job(P.in[17], DM, DM, 0, DM, WB, 0, 0, P.in[16], scr, gw, NGW, lane);
        tr_job(P.in[18], DM, DM, 0, DM, WOUT, 0, 0, nullptr, scr, gw, NGW, lane);
        for (int r = gw; r < NTOK + 16; r += NGW) {
            const bool ism = r >= NTOK; const int rr = ism ? r - NTOK : r;
            const float* xr = ism ? meta + (size_t)rr * DM : (rr < NP_ROWS ? x_p + (size_t)rr * DM : x_s + (size_t)(rr - NP_ROWS) * DM);
            bf16_t* orow = ism ? HBM + (size_t)rr * DM : HB + (size_t)rr * DM;
            float s = 0.f;
#pragma unroll
            for (int j = 0; j < 4; ++j) { const f32x4 v = *(const f32x4*)(xr + 4 * lane + 256 * j); s += (v[0] * v[0] + v[1] * v[1]) + (v[2] * v[2] + v[3] * v[3]);
                *(unsigned long long*)(orow + 4 * lane + 256 * j) = (unsigned long long)pk2(v[0], v[1]) | ((unsigned long long)pk2(v[2], v[3]) << 32); }
            s = wave_sum(s);
            if (lane == 0) { if (ism) SSM0[rr] = s; else SS0[rr] = s; }
        }
        for (int i = gt; i < NTOK; i += NGT) { SS1[i] = 0.f; SS2[i] = 0.f; SS3[i] = 0.f; }
        if (gt < 16) SSM1[gt] = 0.f;
        for (int i = gt; i < 2048; i += NGT) { const int d = i >> 10, w = i & 1023; const float* t = P.in[15]; LBV[i] = fsigmoid(t[d * 2048 + w] - t[d * 2048 + 1024 + w]); }
    }
    grid.sync();

    {
        IDS;
        if (gw < 176) {
            const int j0 = 16 * gw, brow = (j0 / 128) * 256 + (j0 % 128);
            const f32x4 ag = sg16(HBM, DM, WGU1 + (size_t)brow * DM, DM, lane), au = sg16(HBM, DM, WGU1 + (size_t)(brow + 128) * DM, DM, lane);
#pragma unroll
            for (int j = 0; j < 4; ++j) { const int row = 4 * (lane >> 4) + j; const float s = __builtin_amdgcn_rsqf(SSM0[row] * (1.f / DM) + EPS);
                ACTM[(size_t)row * DFF + j0 + (lane & 15)] = (bf16_t)f2bf(fsilu(ag[j] * s) * (au[j] * s)); }
        }
        pg8::Gemm g{HB, WGU1, NTOK, 2 * DFF, DM}; pg8::StaticOrder S; S.init(NTOK, 2 * DFF, G, bx);
        pg8::EpiGU E{ACT0, ACT1, NP_ROWS, SS0, 0};
        pg8::gemm_phase<pg8::EpiGU, pg8::StaticOrder, true, true>(lds, g, S, E);
    }
    GSYNC;
    {
        IDS;
        if (gw < 64) {
            const f32x4 a = sg16(ACTM, DFF, WD1 + (size_t)(16 * gw) * DFF, DFF, lane);
#pragma unroll
            for (int j = 0; j < 4; ++j) { const int row = 4 * (lane >> 4) + j, col = 16 * gw + (lane & 15); const float v = meta[(size_t)row * DM + col] + 0.5f * a[j];
                HBM[(size_t)row * DM + col] = (bf16_t)f2bf(v); float sq = v * v; sq += __shfl_xor(sq, 1); sq += __shfl_xor(sq, 2); sq += __shfl_xor(sq, 4); sq += __shfl_xor(sq, 8);
                if ((lane & 15) == 0) atomicAdd(SSM1 + row, sq); }
        }
#pragma unroll 1
        for (int h = 0; h < 2; ++h) {
            pg8::Gemm g{h ? ACT1 : ACT0, WD1, NP_ROWS, DM, DFF}; pg8::StaticOrder S; S.init(NP_ROWS, DM, G, bx);
            pg8::EpiRes<0, 0> E{x_p, x_s, HB, nullptr, 0.5f, SS1, h * NP_ROWS};
            pg8::gemm_phase<pg8::EpiRes<0, 0>, pg8::StaticOrder, true, true>(lds, g, S, E);
        }
    }
    GSYNC;

#if STAGE >= 2
#pragma unroll 1
    for (int grp = 0; grp < NGROUPS; ++grp) {
        const int grow0 = grp * GROUP_ROWS;
        const int nseq = grp < 2 ? 4 : 2, SL = grp < 2 ? 2048 : 4096;
        {
            IDS;
            if (grp == 0) {
                for (int t = gw; t < 384 + 2; t += NGW) {
                    if (t < 384) {
                        const int c0 = 16 * t; const f32x4 a = sg16(HBM, DM, WPRE + (size_t)c0 * DM, DM, lane);
#pragma unroll
                        for (int j = 0; j < 4; ++j) { const int row = 4 * (lane >> 4) + j, c = c0 + (lane & 15); const float v = a[j] * __builtin_amdgcn_rsqf(SSM1[row] * (1.f / DM) + EPS);
                            if (c < 2048) XBCM[row * 2048 + c] = (bf16_t)f2bf(v);
                            else if (c < 3072) QM[row * 1024 + c - 2048] = (bf16_t)f2bf(fsilu(v));
                            else if (c < 5120) { const float lb = LBV[c - 3072]; const float f = lb + (1.f - lb) * fsigmoid(v); LOGFM[row * 2048 + c - 3072] = (bf16_t)(pkh2(__logf(f), 0.f) & 0xffffu); }
                            else VM[row * 1024 + c - 5120] = (bf16_t)f2bf(v); }
                    } else {
                        const int c0 = 16 * (t - 384); const f32x4 a = sg16(HBM, DM, WDT + (size_t)c0 * DM, DM, lane);
#pragma unroll
                        for (int j = 0; j < 4; ++j) { const int row = 4 * (lane >> 4) + j, c = c0 + (lane & 15); const float v = a[j] * __builtin_amdgcn_rsqf(SSM1[row] * (1.f / DM) + EPS) + P.in[10][c];
                            DTM[row * 32 + c] = v > 15.f ? v : log1pf(__expf(v)); }
                    }
                }
            }
            for (int t = gw; t < 1024; t += NGW) {
                const int rt = t >> 1, c0 = 16 * (t & 1), r0 = grow0 + 16 * rt;
                const f32x4 a = sg16(HB + (size_t)r0 * DM, DM, WDT + (size_t)c0 * DM, DM, lane);
#pragma unroll
                for (int j = 0; j < 4; ++j) { const int row = r0 + 4 * (lane >> 4) + j, c = c0 + (lane & 15); const float v = a[j] * __builtin_amdgcn_rsqf(SS1[row] * (1.f / DM) + EPS) + P.in[10][c];
                    DT[(size_t)row * 32 + c] = v > 15.f ? v : log1pf(__expf(v)); }
            }
            pg8::Gemm g{HB + (size_t)grow0 * DM, WPRE, GROUP_ROWS, NPRE, DM}; pg8::StaticOrder S; S.init(GROUP_ROWS, NPRE, G, bx);
            pg8::EpiPre E{XBC, QB, LOGF, VB, SS1, LBV, grow0};
            pg8::gemm_phase<pg8::EpiPre, pg8::StaticOrder, true, true>(lds, g, S, E);
        }
        GSYNC;
        {
            IDS;
            const float* cw = P.in[8]; const float* cb = P.in[9];
#pragma unroll 1
            for (int pass = 0; pass < 2; ++pass) {
            if (((pass ^ (wave >> 2)) & 1) == 0) {
            for (int task = gt; task < (GROUP_ROWS / 16) * 256; task += NGT) {
                const int cgp = task & 255, rb = task >> 8, c = 8 * cgp, t0 = 16 * rb, seq0 = (t0 / SL) * SL, tl0 = t0 - seq0;
                float w[5][8], bias[8];
#pragma unroll
                for (int j = 0; j < 5; ++j) { const f32x4 a = *(const f32x4*)(cw + j * 2048 + c), b = *(const f32x4*)(cw + j * 2048 + c + 4); w[j][0] = a[0]; w[j][1] = a[1]; w[j][2] = a[2]; w[j][3] = a[3]; w[j][4] = b[0]; w[j][5] = b[1]; w[j][6] = b[2]; w[j][7] = b[3]; }
                { const f32x4 a = *(const f32x4*)(cb + c), b = *(const f32x4*)(cb + c + 4); bias[0] = a[0]; bias[1] = a[1]; bias[2] = a[2]; bias[3] = a[3]; bias[4] = b[0]; bias[5] = b[1]; bias[6] = b[2]; bias[7] = b[3]; }
                float win[5][8];
#define CONV_LD(dst, tau) do { const int _t = (tau); u32x4 _w = {0u, 0u, 0u, 0u}; \
                    if (_t < 0) _w = *(const u32x4*)(XBCM + (size_t)(16 + _t) * 2048 + c); else if (_t < SL) _w = *(const u32x4*)(XBC + (size_t)(seq0 + _t) * 2048 + c); \
                    unpack8(_w, dst); } while (0)
                CONV_LD(win[0], tl0 - 2); CONV_LD(win[1], tl0 - 1); CONV_LD(win[2], tl0); CONV_LD(win[3], tl0 + 1);
#pragma unroll
                for (int i = 0; i < 16; ++i) {
                    CONV_LD(win[4], tl0 + i + 2);
                    float o[8];
#pragma unroll
                    for (int e = 0; e < 8; ++e) { float a = bias[e];
#pragma unroll
                        for (int j = 0; j < 5; ++j) a += w[j][e] * win[j][e];
                        o[e] = fsilu(a); }
                    *(u32x4*)(XC + (size_t)(t0 + i) * 2048 + c) = pack8(o);
#pragma unroll
                    for (int j = 0; j < 4; ++j)
#pragma unroll
                        for (int e = 0; e < 8; ++e) win[j][e] = win[j + 1][e];
                }
            }
            for (int task = gt; task < nseq * 16 * 256; task += NGT) {
                const int cgp = task & 255, m = (task >> 8) & 15, sq = task >> 12, c = 8 * cgp, seq0 = sq * SL;
                const int sg = grp < 2 ? grp * 4 + sq : 8 + (grp - 2) * 2 + sq;
                float a[8];
                { const f32x4 b0 = *(const f32x4*)(cb + c), b1 = *(const f32x4*)(cb + c + 4); a[0] = b0[0]; a[1] = b0[1]; a[2] = b0[2]; a[3] = b0[3]; a[4] = b1[0]; a[5] = b1[1]; a[6] = b1[2]; a[7] = b1[3]; }
#pragma unroll
                for (int j = 0; j < 5; ++j) { const int mm = m + j - 2; if (mm < 0) continue;
                    const u32x4 wv_ = mm < 16 ? *(const u32x4*)(XBCM + (size_t)mm * 2048 + c) : *(const u32x4*)(XBC + (size_t)(seq0 + mm - 16) * 2048 + c);
                    float xv[8]; unpack8(wv_, xv); const f32x4 w0 = *(const f32x4*)(cw + j * 2048 + c), w1 = *(const f32x4*)(cw + j * 2048 + c + 4);
                    a[0] += w0[0] * xv[0]; a[1] += w0[1] * xv[1]; a[2] += w0[2] * xv[2]; a[3] += w0[3] * xv[3]; a[4] += w1[0] * xv[4]; a[5] += w1[1] * xv[5]; a[6] += w1[2] * xv[6]; a[7] += w1[3] * xv[7]; }
#pragma unroll
                for (int e = 0; e < 8; ++e) a[e] = fsilu(a[e]);
                *(u32x4*)(XCM + ((size_t)sg * 16 + m) * 2048 + c) = pack8(a);
            }
            } else {
            for (int unit = gw; unit < (GROUP_ROWS / 64) * 128; unit += NGW) {
                const int j = unit & 127, ch = unit >> 7; const size_t row = (size_t)ch * 64 + lane;
                const u32x4 qw = *(const u32x4*)(QB + row * 1024 + 8 * j), l0 = *(const u32x4*)(LOGF + row * 2048 + 8 * j), l1 = *(const u32x4*)(LOGF + row * 2048 + 1024 + 8 * j);
                float qv[8], x0[8], x1[8], qe0[8], ke0[8], qe1[8], ke1[8]; unpack8(qw, qv);
                x0[0] = hlo(l0.x); x0[1] = hhi(l0.x); x0[2] = hlo(l0.y); x0[3] = hhi(l0.y); x0[4] = hlo(l0.z); x0[5] = hhi(l0.z); x0[6] = hlo(l0.w); x0[7] = hhi(l0.w);
                x1[0] = hlo(l1.x); x1[1] = hhi(l1.x); x1[2] = hlo(l1.y); x1[3] = hhi(l1.y); x1[4] = hlo(l1.z); x1[5] = hhi(l1.z); x1[6] = hlo(l1.w); x1[7] = hhi(l1.w);
                float* hs = HSC + (size_t)ch * 6144 + 8 * j; float t0s = 0.f, r0s = 0.f, t1s = 0.f, r1s = 0.f;
#pragma unroll
                for (int e = 0; e < 8; ++e) {
                    const float p0 = wave_scan(x0[e], lane), tot0 = lane_bcast(p0, 63), ref0 = lane_bcast(p0, 31);
                    qe0[e] = qv[e] * __expf(p0 - ref0); ke0[e] = (1.f - __expf(x0[e])) * __expf(ref0 - p0);
                    const float p1 = wave_scan(x1[e], lane), tot1 = lane_bcast(p1, 63), b1 = tot1 - p1 + x1[e], ref1 = lane_bcast(b1, 32);
                    qe1[e] = qv[e] * __expf(b1 - ref1); ke1[e] = (1.f - __expf(x1[e])) * __expf(ref1 - b1);
                    if (lane == e) { t0s = tot0; r0s = ref0; t1s = tot1; r1s = ref1; }
                }
                if (lane < 8) { hs[lane] = __expf(t0s); hs[2048 + lane] = __expf(t0s - r0s); hs[4096 + lane] = __expf(r0s);
                                hs[1024 + lane] = __expf(t1s); hs[2048 + 1024 + lane] = __expf(t1s - r1s); hs[4096 + 1024 + lane] = __expf(r1s); }
                *(u32x4*)(QB + row * 1024 + 8 * j) = pack8(qe0); *(u32x4*)(QE1 + row * 1024 + 8 * j) = pack8(qe1);
                *(u32x4*)(LOGF + row * 2048 + 8 * j) = pack8(ke0); *(u32x4*)(LOGF + row * 2048 + 1024 + 8 * j) = pack8(ke1);
            }
            }
            }
#undef CONV_LD
        }
        GSYNC;
        {
            WSD;
            const int nitems = nseq * 64;
#pragma unroll 1
            for (int item = bx; item < nitems; item += G) {
                ScanItem it; const int half = nseq * 32; it.kind = item / half; const int rem = item % half, sq = rem / 32, r2 = rem % 32;
                const int sg = grp < 2 ? grp * 4 + sq : 8 + (grp - 2) * 2 + sq;
                it.nC = SL / 64; it.row0 = sq * SL; it.grow0 = grow0 + sq * SL;
                it.xc = XC; it.xcm = XCM + (size_t)sg * 16 * 2048; it.dt = DT; it.dtm = DTM; it.q = QB; it.logf = LOGF; it.v = VB; it.logfm = LOGFM; it.vm = VM;
                if (it.kind == 0) { it.head = r2 >> 1; it.dir = r2 & 1; it.vh = 0; it.Aneg = -__expf(P.in[11][it.dir * 16 + it.head]); it.out = it.dir ? YB : YF; it.ocol = it.head * 64;
                    it.dtm = DTM + it.dir * 16; scan_run<0>(lds, it); }
                else { it.head = r2 >> 2; it.dir = (r2 >> 1) & 1; it.vh = r2 & 1; it.Aneg = 0.f; it.out = it.dir ? OB : OF; it.ocol = it.head * 128 + it.vh * 64;
                    it.logfm = LOGFM + it.dir * 1024; it.q = it.dir ? QE1 : QB; it.hsc = HSC; scan_run<1>(lds, it); }
            }
            const int gp = nitems >= G ? G : G - nitems, cp = nitems >= G ? bx : bx - nitems;
            pg8::Gemm g{HB + (size_t)grow0 * DM, WPOST, GROUP_ROWS, NPOST / 2, DM}; pg8::StaticOrder S; S.init(GROUP_ROWS, NPOST / 2, gp, cp);
            pg8::EpiPost E{ZG, SS1, grow0, 0};
            pg8::gemm_phase<pg8::EpiPost, pg8::StaticOrder, true, true>(lds, g, S, E);
            if (grp == 2 && cp >= 0) {
                const int tid2 = fresh_tid(), lane2 = tid2 & 63, wave2 = __builtin_amdgcn_readfirstlane(tid2 >> 6);
                LAS float* scr = (LAS float*)(lds + wave2 * 16384);
                tr_job(P.in[20], 2 * DFF, DM, 0, 2 * DFF, WGU2, 0, 1, P.in[19], scr, cp * 8 + wave2, gp * 8, lane2);
                tr_job(P.in[21], DM, DFF, 0, DM, WD2, 0, 0, nullptr, scr, cp * 8 + wave2, gp * 8, lane2);
            }
        }
        GSYNC;
        {
            IDS;
            const float* dsk = P.in[12];
            bf16_t* const sa = (grp & 1) ? SA : PARK; bf16_t* const sb = (grp & 1) ? SB : PARK + (size_t)GROUP_ROWS * DM;
            for (int r = gw; r < GROUP_ROWS; r += NGW) {
                float ya[2][8], oa[2][8]; float ssq = 0.f;
#pragma unroll
                for (int j = 0; j < 2; ++j) { const int c = 8 * lane + 512 * j; float yf[8], yb[8], xs[8], zz[8];
                    unpack8(*(const u32x4*)(YF + (size_t)r * 1024 + c), yf); unpack8(*(const u32x4*)(YB + (size_t)r * 1024 + c), yb);
                    unpack8(*(const u32x4*)(XC + (size_t)r * 2048 + c), xs); unpack8(*(const u32x4*)(ZG + (size_t)r * 2048 + c), zz);
                    const float dk = dsk[c >> 6];
#pragma unroll
                    for (int e = 0; e < 8; ++e) { const float v = (yf[e] + yb[e] + dk * xs[e]) * zz[e]; ya[j][e] = v; ssq += v * v; } }
                ssq = wave_sum(ssq); const float rstd = __builtin_amdgcn_rsqf(ssq * (1.f / DM) + EPS);
#pragma unroll
                for (int j = 0; j < 2; ++j) { const int c = 8 * lane + 512 * j; float of[8], ob[8], hg[8]; float hs = 0.f;
                    unpack8(*(const u32x4*)(OF + (size_t)r * 1024 + c), of); unpack8(*(const u32x4*)(OB + (size_t)r * 1024 + c), ob); unpack8(*(const u32x4*)(ZG + (size_t)r * 2048 + 1024 + c), hg);
#pragma unroll
                    for (int e = 0; e < 8; ++e) { const float v = of[e] + ob[e]; oa[j][e] = v; hs += v * v; }
                    hs += __shfl_xor(hs, 1); hs += __shfl_xor(hs, 2); hs += __shfl_xor(hs, 4); hs += __shfl_xor(hs, 8);
                    const float hr = __builtin_amdgcn_rsqf(hs * (1.f / 128.f) + EPS);
#pragma unroll
                    for (int e = 0; e < 8; ++e) oa[j][e] = oa[j][e] * hr * hg[e]; }
#pragma unroll
                for (int j = 0; j < 2; ++j) { const int c = 8 * lane + 512 * j;
#pragma unroll
                    for (int e = 0; e < 8; ++e) ya[j][e] *= rstd;
                    *(u32x4*)(sa + (size_t)r * 1024 + c) = pack8(ya[j]); *(u32x4*)(sb + (size_t)r * 1024 + c) = pack8(oa[j]); }
            }
        }
        GSYNC;
        if (grp & 1) {
            const int prow0 = (grp - 1) * GROUP_ROWS;
            {
                WSD;
                pg8::Gemm g{HB + (size_t)prow0 * DM, WPOST + (size_t)(NPOST / 2) * DM, 2 * GROUP_ROWS, NPOST / 2, DM}; pg8::StaticOrder S; S.init(2 * GROUP_ROWS, NPOST / 2, G, bx);
                pg8::EpiPost E{GATES2, SS1, prow0, 1};
                pg8::gemm_phase<pg8::EpiPost, pg8::StaticOrder, true, true>(lds, g, S, E);
            }
            GSYNC;
            {
                WSD;
#pragma unroll 1
                for (int gi = 0; gi < 2; ++gi) {
                    const bf16_t* sa = gi ? SA : PARK; const bf16_t* sb = gi ? SB : PARK + (size_t)GROUP_ROWS * DM; const int c = (bx + gi * (G / 2)) % G;
                    { pg8::Gemm g{sa, WA, GROUP_ROWS, DM, DM}; pg8::StaticOrder S; S.init(GROUP_ROWS, DM, G, c); pg8::EpiMerge<1> E{MERGED2, GATES2, gi * GROUP_ROWS};
                      pg8::gemm_phase<pg8::EpiMerge<1>, pg8::StaticOrder, true, true>(lds, g, S, E); }
                    { pg8::Gemm g{sb, WB, GROUP_ROWS, DM, DM}; pg8::StaticOrder S; S.init(GROUP_ROWS, DM, G, c); pg8::EpiMerge<0> E{MERGED2, GATES2, gi * GROUP_ROWS};
                      pg8::gemm_phase<pg8::EpiMerge<0>, pg8::StaticOrder, true, true>(lds, g, S, E); }
                }
            }
            GSYNC;
            {
                WSD;
                pg8::Gemm g{MERGED2, WOUT, 2 * GROUP_ROWS, DM, DM}; pg8::StaticOrder S; S.init(2 * GROUP_ROWS, DM, G, bx);
                pg8::EpiRes<1, 0> E{nullptr, nullptr, HB, nullptr, 1.0f, SS2, prow0};
                pg8::gemm_phase<pg8::EpiRes<1, 0>, pg8::StaticOrder, true, true>(lds, g, S, E);
            }
            GSYNC;
        }
    }
#define SSF SS2
#else
#define SSF SS1
#endif

#pragma unroll 1
    for (int h = 0; h < 2; ++h) {
        {
            WSD;
            pg8::Gemm g{HB + (size_t)h * NP_ROWS * DM, WGU2, NP_ROWS, 2 * DFF, DM}; pg8::StaticOrder S; S.init(NP_ROWS, 2 * DFF, G, bx);
            pg8::EpiGU E{ACT0, ACT0, NP_ROWS, SSF, h * NP_ROWS};
            pg8::gemm_phase<pg8::EpiGU, pg8::StaticOrder, true, true>(lds, g, S, E);
        }
        GSYNC;
        {
            WSD;
            pg8::Gemm g{ACT0, WD2, NP_ROWS, DM, DFF}; pg8::StaticOrder S; S.init(NP_ROWS, DM, G, bx);
            pg8::EpiRes<1, 1> E{nullptr, nullptr, HB, P.out, 0.5f, SS3, h * NP_ROWS};
            pg8::gemm_phase<pg8::EpiRes<1, 1>, pg8::StaticOrder, true, true>(lds, g, S, E);
        }
        GSYNC;
    }
    {
        IDS;
        const float* fw = P.in[22];
        for (int r = gw; r < NTOK; r += NGW) {
            const float rstd = __builtin_amdgcn_rsqf(SS3[r] * (1.f / DM) + EPS); float* o = P.out + (size_t)r * DM;
#pragma unroll
            for (int j = 0; j < 4; ++j) { const int c = 4 * lane + 256 * j; f32x4 v = *(const f32x4*)(o + c); const f32x4 w = *(const f32x4*)(fw + c);
                v[0] *= rstd * w[0]; v[1] *= rstd * w[1]; v[2] *= rstd * w[2]; v[3] *= rstd * w[3]; *(f32x4*)(o + c) = v; }
        }
    }
}

extern "C" void kernel_launch(void* const* d_in, const int* in_sizes, int n_in, void* d_out, int out_size, void* d_ws, size_t ws_size, hipStream_t stream) {
    static int grid = 0;
    if (grid == 0) {
        if (n_in != 23 || out_size != NTOK * DM || ws_size < WS_END) { fprintf(stderr, "kernel_launch: unexpected shapes (n_in %d out %d ws %zu)\n", n_in, out_size, ws_size); grid = -1; return; }
        int dev = 0, cus = 0, per_cu = 0;
        hipGetDevice(&dev); hipDeviceGetAttribute(&cus, hipDeviceAttributeMultiprocessorCount, dev);
        hipFuncSetAttribute((const void*)fwd_mega, hipFuncAttributeMaxDynamicSharedMemorySize, LDS_BYTES);
        hipOccupancyMaxActiveBlocksPerMultiprocessor(&per_cu, (const void*)fwd_mega, 512, LDS_BYTES);
        if (per_cu < 1) { fprintf(stderr, "kernel_launch: occupancy query says %d blocks per CU\n", per_cu); grid = -1; return; }
        grid = cus;
    }
    if (grid < 0) return;
    Params p{};
    for (int i = 0; i < 23; ++i) p.in[i] = (const float*)d_in[i];
    p.out = (float*)d_out; p.ws = (unsigned char*)d_ws;
    (void)hipMemsetAsync((unsigned char*)d_ws + WS_BAR, 0, 16384, stream);
    void* args[] = {&p};
    hipError_t e = hipLaunchCooperativeKernel((const void*)fwd_mega, dim3(grid), dim3(512), args, LDS_BYTES, stream);
    if (e != hipSuccess) fprintf(stderr, "cooperative launch failed: %s (grid %d)\n", hipGetErrorString(e), grid);
}
```

```cpp
#include <hip/hip_runtime.h>
#include <hip/hip_cooperative_groups.h>
#include <cstdio>
#include <cstdint>
namespace cg = cooperative_groups;

#ifndef STAGE
#define STAGE 99
#endif

#define LAS __attribute__((address_space(3)))
typedef unsigned short bf16_t;
typedef short bf16x8 __attribute__((ext_vector_type(8)));
typedef float f32x4 __attribute__((ext_vector_type(4)));
typedef unsigned u32x4 __attribute__((ext_vector_type(4)));

constexpr int DM = 1024, DFF = 2816, NTOK = 32768, NP_ROWS = 16384;
constexpr int GROUP_ROWS = 8192, NGROUPS = 4;
constexpr float EPS = 1e-6f;
constexpr int IN_COLS = 10272;
constexpr int NPRE = 6144, NPOST = 4096;

constexpr size_t MiB = 1u << 20;
constexpr size_t WS_SS0 = 0, WS_SS1 = 128 * 1024, WS_SS2 = 256 * 1024, WS_SS3 = 384 * 1024, WS_SSM0 = 512 * 1024, WS_SSM1 = 512 * 1024 + 256, WS_LBV = 520 * 1024;
constexpr size_t WS_BAR = 640 * 1024;
constexpr size_t WS_META = 1 * MiB;
constexpr size_t M_HBM = WS_META, M_ACTM = WS_META + 32 * 1024, M_XBCM = WS_META + 128 * 1024, M_QM = WS_META + 192 * 1024, M_LOGFM = WS_META + 224 * 1024,
                 M_VM = WS_META + 288 * 1024, M_DTM = WS_META + 320 * 1024, M_XCM = WS_META + 324 * 1024;
constexpr size_t WS_DT = 3 * MiB;
constexpr size_t WS_WGU1 = 7 * MiB, WS_WD1 = 18 * MiB, WS_WGU2 = 23 * MiB + 512 * 1024, WS_WD2 = 34 * MiB + 512 * 1024, WS_WPRE = 40 * MiB, WS_WPOST = 52 * MiB,
                 WS_WA = 60 * MiB, WS_WB = 62 * MiB, WS_WOUT = 64 * MiB, WS_WDT = 66 * MiB;
constexpr size_t WS_HB = 67 * MiB;
constexpr size_t WS_F = 131 * MiB;
constexpr size_t WS_QB = WS_F, WS_VB = WS_F + 16 * MiB, WS_ZG = WS_F + 32 * MiB, WS_GATES = WS_F + 64 * MiB;
constexpr size_t WS_QE1 = 227 * MiB, WS_HSC = 243 * MiB;
constexpr size_t WS_END = 256 * MiB;
constexpr size_t DO_Y = 0, DO_XC = 32 * MiB, DO_LOGF = 64 * MiB, DO_OF = 96 * MiB, DO_OB = 112 * MiB;

__device__ __forceinline__ unsigned f2bf(float f) { unsigned u = __builtin_bit_cast(unsigned, f); return (u + 0x7fffu + ((u >> 16) & 1u)) >> 16; }
typedef float f32x2_t __attribute__((ext_vector_type(2)));
typedef __bf16 bf16x2_t __attribute__((ext_vector_type(2)));
__device__ __forceinline__ unsigned pk2(float lo, float hi) { const f32x2_t v = {lo, hi}; const bf16x2_t b = __builtin_convertvector(v, bf16x2_t); return __builtin_bit_cast(unsigned, b); }
__device__ __forceinline__ float bflo(unsigned w) { return __builtin_bit_cast(float, w << 16); }
__device__ __forceinline__ float bfhi(unsigned w) { return __builtin_bit_cast(float, w & 0xffff0000u); }
__device__ __forceinline__ float bf2f(bf16_t h) { return __builtin_bit_cast(float, ((unsigned)h) << 16); }
__device__ __forceinline__ float frcp(float x) { return __builtin_amdgcn_rcpf(x); }
__device__ __forceinline__ float fsigmoid(float x) { return frcp(1.f + __expf(-x)); }
__device__ __forceinline__ float fsilu(float x) { return x * frcp(1.f + __expf(-x)); }
__device__ __forceinline__ unsigned pkh2(float lo, float hi) { _Float16 a = (_Float16)lo, b = (_Float16)hi; return (unsigned)__builtin_bit_cast(unsigned short, a) | ((unsigned)__builtin_bit_cast(unsigned short, b) << 16); }
__device__ __forceinline__ float hlo(unsigned w) { return (float)__builtin_bit_cast(_Float16, (unsigned short)(w & 0xffffu)); }
__device__ __forceinline__ float hhi(unsigned w) { return (float)__builtin_bit_cast(_Float16, (unsigned short)(w >> 16)); }
__device__ __forceinline__ int fresh_tid() { int t = threadIdx.x; asm volatile("" : "+v"(t)); return t; }
__device__ __forceinline__ float wave_sum(float v) {
#pragma unroll
    for (int o = 1; o < 64; o <<= 1) v += __shfl_xor(v, o);
    return v;
}
template <int CTRL, int RM> __device__ __forceinline__ float dppmov(float v) { return __builtin_bit_cast(float, __builtin_amdgcn_update_dpp(0, __builtin_bit_cast(int, v), CTRL, RM, 0xf, false)); }
__device__ __forceinline__ float wave_scan(float v, int) {
    v += dppmov<0x111, 0xf>(v); v += dppmov<0x112, 0xf>(v); v += dppmov<0x114, 0xf>(v); v += dppmov<0x118, 0xf>(v);
    v += dppmov<0x142, 0xa>(v); v += dppmov<0x143, 0xc>(v);
    return v;
}
__device__ __forceinline__ float lane_bcast(float v, int l) { return __builtin_bit_cast(float, __builtin_amdgcn_readlane(__builtin_bit_cast(int, v), l)); }
__device__ __forceinline__ void unpack8(const u32x4 w, float (&f)[8]) {
    f[0] = bflo(w.x); f[1] = bfhi(w.x); f[2] = bflo(w.y); f[3] = bfhi(w.y); f[4] = bflo(w.z); f[5] = bfhi(w.z); f[6] = bflo(w.w); f[7] = bfhi(w.w);
}
__device__ __forceinline__ u32x4 pack8(const float (&f)[8]) { u32x4 w; w.x = pk2(f[0], f[1]); w.y = pk2(f[2], f[3]); w.z = pk2(f[4], f[5]); w.w = pk2(f[6], f[7]); return w; }

namespace pg8 {
#define PG8_LAS __attribute__((address_space(3)))
constexpr int BM = 256, BK = 64, HALF = 128, HTB = HALF * BK * 2, STAGE_BYTES = 8 * HTB, NXCD = 8, WGM = 8;
__host__ __device__ __forceinline__ int lds_byte(int r, int c) { const int st = (r >> 4) * 2 + (c >> 5), rr = r & 15, cc = c & 31, ob = rr * 64 + cc * 2; return st * 1024 + (ob ^ (((ob >> 9) & 1) << 5)); }
__host__ __device__ __forceinline__ void stage_rc(int b, int& R, int& C) { const int st = b / 1024, sb = b % 1024, swz = sb ^ (((sb >> 9) & 1) << 5); R = (st >> 1) * 16 + swz / 64; C = (st & 1) * 32 + (swz % 64) / 2; }
__host__ __device__ __forceinline__ int perm32(int rho) { const int n = rho >> 4, i = rho & 15; return 8 * (i >> 2) + 4 * n + (i & 3); }
struct Unit { int pm, pn; };
struct Gemm { const bf16_t* A; const bf16_t* Bt; int M, N, K; };
struct StaticOrder {
    int nM, nN, nwg, G, c;
    __device__ void init(int M, int N, int G_, int c_) { nM = M / BM; nN = N / BM; nwg = nM * nN; G = G_; c = c_; }
    __device__ bool next(int i, Unit& u) const {
        if (c < 0) return false;
        const long L = (long)i * G + c; if (L >= nwg) return false;
        int wgid = (int)L; { const int q = nwg / NXCD, r = nwg % NXCD, xcd = wgid % NXCD, off = wgid / NXCD; wgid = (xcd < r ? xcd * (q + 1) : r * (q + 1) + (xcd - r) * q) + off; }
        const int nig = WGM * nN, gid = wgid / nig, fm = gid * WGM, gsz = (nM - fm) < WGM ? (nM - fm) : WGM;
        u.pm = fm + ((wgid % nig) % gsz); u.pn = (wgid % nig) / gsz; return true;
    }
    __device__ __forceinline__ void a_ready(const Unit&) const {}
    __device__ __forceinline__ void done(const Unit&) const {}
};

template <class Epi, class Sched, bool ALIGN_EPI = false, bool SP2 = false>
__device__ __forceinline__ void gemm_phase(PG8_LAS unsigned char* lds, const Gemm g, const Sched& S, const Epi& E) {
    const int tid = fresh_tid(), wid = __builtin_amdgcn_readfirstlane(tid >> 6), lane = tid & 63, wr = wid >> 2, wc = wid & 3, fr = lane & 15, fq = lane >> 4;
    const int K = g.K, nt = K / BK;
    unsigned voffA[2], voffB[2];
#pragma unroll
    for (int i = 0; i < 2; ++i) { int R, C; stage_rc(tid * 16 + i * 8192, R, C); const int Rb = Epi::PERM ? ((R & ~31) + perm32(R & 31)) : R;
        voffA[i] = (unsigned)(R * K + C) * 2u; voffB[i] = (unsigned)(Rb * K + C) * 2u; }
    const size_t kstep = (size_t)(BK * 2);
    const size_t hstep = (size_t)HALF * K * 2;
    const size_t tstep = 2 * hstep;
    const unsigned ldsw = (unsigned)wid * 1024u;
    const int aoff = lds_byte(wr * 64 + fr, fq * 8), boff = lds_byte(wc * 32 + fr, fq * 8);
#define PG8_SA(b, h) (((b) * 2 + (h)) * HTB)
#define PG8_SB(b, h) ((4 + (b) * 2 + (h)) * HTB)
#define PG8_STAGE(bufoff, gbase, voff) do { _Pragma("unroll") for (int _i = 0; _i < 2; ++_i) \
        __builtin_amdgcn_global_load_lds((const unsigned*)((const char*)(gbase) + (voff)[_i]), (PG8_LAS unsigned*)(lds + (bufoff) + ldsw + _i * 8192), 16, 0, 0); } while (0)
#define PG8_LDA(dst, b, h) do { _Pragma("unroll") for (int m = 0; m < 4; ++m) _Pragma("unroll") for (int k = 0; k < 2; ++k) dst[m][k] = *(const PG8_LAS bf16x8*)(lds + PG8_SA(b, h) + aoff + m * 2048 + k * 1024); } while (0)
#define PG8_LDB(dst, b, h) do { _Pragma("unroll") for (int n = 0; n < 2; ++n) _Pragma("unroll") for (int k = 0; k < 2; ++k) dst[n][k] = *(const PG8_LAS bf16x8*)(lds + PG8_SB(b, h) + boff + n * 2048 + k * 1024); } while (0)
#define PG8_MMA(ai, bj, At, Bt) do { __builtin_amdgcn_s_setprio(1); _Pragma("unroll") for (int m = 0; m < 4; ++m) _Pragma("unroll") for (int n = 0; n < 2; ++n) _Pragma("unroll") for (int k = 0; k < 2; ++k) \
        acc[ai][bj][m][n] = __builtin_amdgcn_mfma_f32_16x16x32_bf16(Bt[n][k], At[m][k], acc[ai][bj][m][n], 0, 0, 0); __builtin_amdgcn_s_setprio(0); } while (0)
#define PG8_WAIT_V(n) asm volatile("s_waitcnt vmcnt(" #n ")" ::: "memory")
#define PG8_WAIT_L(n) asm volatile("s_waitcnt lgkmcnt(" #n ")" ::: "memory")
#define PG8_BAR __builtin_amdgcn_s_barrier()
#define PG8_SCHED __builtin_amdgcn_sched_barrier(0)
    Unit cur, nxt; int ui = 0;
    if (!S.next(0, cur)) return;
    f32x4 acc[2][2][4][2];
#pragma unroll
    for (int a = 0; a < 2; ++a)
#pragma unroll
        for (int b = 0; b < 2; ++b)
#pragma unroll
            for (int m = 0; m < 4; ++m)
#pragma unroll
                for (int n = 0; n < 2; ++n) acc[a][b][m][n] = (f32x4){0.f, 0.f, 0.f, 0.f};
    bf16x8 At[4][2], B0[2][2], B1[2][2];
    const char* cA = (const char*)g.A + (size_t)cur.pm * tstep; const char* cB = (const char*)g.Bt + (size_t)cur.pn * tstep;
    S.a_ready(cur);
    if constexpr (SP2) {
        PG8_STAGE(PG8_SB(0, 0), cB, voffB); PG8_STAGE(PG8_SB(0, 1), cB + hstep, voffB); PG8_STAGE(PG8_SA(0, 0), cA, voffA); PG8_STAGE(PG8_SA(0, 1), cA + hstep, voffA);
        if (wr == 1) PG8_BAR;
        PG8_WAIT_V(2); PG8_BAR;
        PG8_STAGE(PG8_SB(1, 0), cB + kstep, voffB); PG8_STAGE(PG8_SA(1, 0), cA + kstep, voffA); PG8_STAGE(PG8_SB(1, 1), cB + hstep + kstep, voffB);
        PG8_WAIT_V(6); PG8_BAR;
    } else {
        PG8_STAGE(PG8_SB(0, 0), cB, voffB); PG8_STAGE(PG8_SA(0, 0), cA, voffA); PG8_STAGE(PG8_SB(0, 1), cB + hstep, voffB); PG8_STAGE(PG8_SA(0, 1), cA + hstep, voffA);
        if (wr == 1) PG8_BAR;
        PG8_WAIT_V(4); PG8_BAR;
        PG8_STAGE(PG8_SB(1, 0), cB + kstep, voffB); PG8_STAGE(PG8_SA(1, 0), cA + kstep, voffA); PG8_STAGE(PG8_SB(1, 1), cB + hstep + kstep, voffB);
        PG8_WAIT_V(6); PG8_BAR;
    }
    for (;;) {
        const bool has_next = S.next(ui + 1, nxt);
        const char* nA = has_next ? (const char*)g.A + (size_t)nxt.pm * tstep : cA; const char* nB = has_next ? (const char*)g.Bt + (size_t)nxt.pn * tstep : cB;
        for (int t = 0; t < nt; t += 2) {
            const bool last = (t == nt - 2);
            const char* a1 = cA + (size_t)(t + 1) * kstep;
            const char* a2 = last ? nA : cA + (size_t)(t + 2) * kstep; const char* b2 = last ? nB : cB + (size_t)(t + 2) * kstep;
            const char* a3 = a2 + kstep; const char* b3 = b2 + kstep;
            if (last && has_next) S.a_ready(nxt);
            if constexpr (SP2) {
            PG8_LDB(B0, 0, 0); PG8_LDB(B1, 0, 1); PG8_SCHED; PG8_LDA(At, 0, 0); PG8_STAGE(PG8_SA(1, 1), a1 + hstep, voffA);
            PG8_WAIT_V(8); PG8_WAIT_L(0); PG8_BAR; PG8_MMA(0, 0, At, B0); PG8_MMA(0, 1, At, B1); PG8_BAR; PG8_SCHED;
            PG8_LDA(At, 0, 1); PG8_STAGE(PG8_SB(0, 0), b2, voffB); PG8_STAGE(PG8_SB(0, 1), b2 + hstep, voffB); PG8_STAGE(PG8_SA(0, 0), a2, voffA);
            PG8_WAIT_V(8); PG8_WAIT_L(0); PG8_BAR; PG8_MMA(1, 0, At, B0); PG8_MMA(1, 1, At, B1); PG8_BAR; PG8_SCHED;
            PG8_LDB(B0, 1, 0); PG8_LDB(B1, 1, 1); PG8_SCHED; PG8_LDA(At, 1, 0); PG8_STAGE(PG8_SA(0, 1), a2 + hstep, voffA);
            PG8_WAIT_V(8); PG8_WAIT_L(0); PG8_BAR; PG8_MMA(0, 0, At, B0); PG8_MMA(0, 1, At, B1); PG8_BAR; PG8_SCHED;
            PG8_LDA(At, 1, 1); PG8_STAGE(PG8_SB(1, 0), b3, voffB); PG8_STAGE(PG8_SB(1, 1), b3 + hstep, voffB); PG8_STAGE(PG8_SA(1, 0), a3, voffA);
            PG8_WAIT_V(8); PG8_WAIT_L(0); PG8_BAR; PG8_MMA(1, 0, At, B0); PG8_MMA(1, 1, At, B1); PG8_BAR; PG8_SCHED;
            } else {
            PG8_LDB(B0, 0, 0); PG8_SCHED; PG8_LDA(At, 0, 0); PG8_STAGE(PG8_SA(1, 1), a1 + hstep, voffA);
            PG8_WAIT_L(8); PG8_BAR; PG8_WAIT_L(0); PG8_MMA(0, 0, At, B0); PG8_BAR; PG8_SCHED;
            PG8_LDB(B1, 0, 1); PG8_STAGE(PG8_SB(0, 0), b2, voffB);
            PG8_BAR; PG8_WAIT_L(0); PG8_MMA(0, 1, At, B1); PG8_BAR;
            PG8_LDA(At, 0, 1); PG8_STAGE(PG8_SA(0, 0), a2, voffA);
            PG8_BAR; PG8_WAIT_L(0); PG8_MMA(1, 0, At, B0); PG8_BAR; PG8_SCHED;
            PG8_STAGE(PG8_SB(0, 1), b2 + hstep, voffB);
            PG8_WAIT_V(6); PG8_BAR; PG8_MMA(1, 1, At, B1); PG8_BAR;
            PG8_LDB(B0, 1, 0); PG8_SCHED; PG8_LDA(At, 1, 0); PG8_STAGE(PG8_SA(0, 1), a2 + hstep, voffA);
            PG8_WAIT_L(8); PG8_BAR; PG8_WAIT_L(0); PG8_MMA(0, 0, At, B0); PG8_BAR; PG8_SCHED;
            PG8_LDB(B1, 1, 1); PG8_STAGE(PG8_SB(1, 0), b3, voffB);
            PG8_BAR; PG8_WAIT_L(0); PG8_MMA(0, 1, At, B1); PG8_BAR;
            PG8_LDA(At, 1, 1); PG8_STAGE(PG8_SA(1, 0), a3, voffA);
            PG8_BAR; PG8_WAIT_L(0); PG8_MMA(1, 0, At, B0); PG8_BAR; PG8_SCHED;
            PG8_STAGE(PG8_SB(1, 1), b3 + hstep, voffB);
            PG8_WAIT_V(6); PG8_BAR; PG8_MMA(1, 1, At, B1); PG8_BAR;
            }
        }
        if constexpr (ALIGN_EPI) { if (wr == 0) PG8_BAR; }
        E(acc, cur, wr, wc, fr, fq); S.done(cur);
        if (!has_next) break;
#pragma unroll
        for (int a = 0; a < 2; ++a)
#pragma unroll
            for (int b = 0; b < 2; ++b)
#pragma unroll
                for (int m = 0; m < 4; ++m)
#pragma unroll
                    for (int n = 0; n < 2; ++n) acc[a][b][m][n] = (f32x4){0.f, 0.f, 0.f, 0.f};
        cur = nxt; cA = nA; cB = nB; ++ui;
        if constexpr (ALIGN_EPI) { if (wr == 1) PG8_BAR; }
    }
    PG8_WAIT_V(0);
    if constexpr (!ALIGN_EPI) { if (wr == 0) PG8_BAR; }
    PG8_BAR;
#undef PG8_SA
#undef PG8_SB
#undef PG8_STAGE
#undef PG8_LDA
#undef PG8_LDB
#undef PG8_MMA
#undef PG8_WAIT_V
#undef PG8_WAIT_L
#undef PG8_BAR
#undef PG8_SCHED
}

typedef f32x4 Acc[2][2][4][2];

struct EpiGU {
    static constexpr bool PERM = true;
    bf16_t* act0; bf16_t* act1; int split_row; const float* ss; int row_base;
    __device__ __forceinline__ void operator()(const Acc& acc, const Unit& u, int wr, int wc, int fr, int fq) const {
        const int row0 = row_base + u.pm * BM + wr * 64 + fr, col = u.pn * 128 + wc * 32 + 8 * fq;
#pragma unroll
        for (int ai = 0; ai < 2; ++ai)
#pragma unroll
            for (int m = 0; m < 4; ++m) {
                const int r = row0 + ai * HALF + m * 16;
                const float s = __builtin_amdgcn_rsqf(ss[r] * (1.f / DM) + EPS);
                bf16_t* dst = (r < split_row ? act0 + (size_t)r * DFF : act1 + (size_t)(r - split_row) * DFF) + col;
                float o[8];
#pragma unroll
                for (int n = 0; n < 2; ++n)
#pragma unroll
                    for (int i = 0; i < 4; ++i) { const float g = acc[ai][0][m][n][i] * s, up = acc[ai][1][m][n][i] * s; o[4 * n + i] = fsilu(g) * up; }
                *(u32x4*)dst = pack8(o);
            }
    }
};

template <int RES  , int OUT  >
struct EpiRes {
    static constexpr bool PERM = true;
    const float* xp; const float* xs; bf16_t* hb; float* outf; float alpha; float* ss_out; int row_base;
    __device__ __forceinline__ void operator()(const Acc& acc, const Unit& u, int wr, int wc, int fr, int fq) const {
        const int row0 = row_base + u.pm * BM + wr * 64 + fr, col0 = u.pn * BM + wc * 32 + 8 * fq;
#pragma unroll
        for (int ai = 0; ai < 2; ++ai)
#pragma unroll
            for (int m = 0; m < 4; ++m) {
                const int r = row0 + ai * HALF + m * 16; float sq = 0.f;
#pragma unroll
                for (int bj = 0; bj < 2; ++bj) {
                    const int c = col0 + bj * HALF; float res[8], v[8];
                    if (RES == 0) { const float* xr = (r < NP_ROWS ? xp + (size_t)r * DM : xs + (size_t)(r - NP_ROWS) * DM) + c; const f32x4 a = *(const f32x4*)xr, b = *(const f32x4*)(xr + 4);
                        res[0] = a[0]; res[1] = a[1]; res[2] = a[2]; res[3] = a[3]; res[4] = b[0]; res[5] = b[1]; res[6] = b[2]; res[7] = b[3]; }
                    else { const u32x4 w = *(const u32x4*)(hb + (size_t)r * DM + c); unpack8(w, res); }
#pragma unroll
                    for (int n = 0; n < 2; ++n)
#pragma unroll
                        for (int i = 0; i < 4; ++i) { const float t = res[4 * n + i] + alpha * acc[ai][bj][m][n][i]; v[4 * n + i] = t; sq += t * t; }
                    if (OUT == 0) *(u32x4*)(hb + (size_t)r * DM + c) = pack8(v);
                    else { float* o = outf + (size_t)r * DM + c; *(f32x4*)o = (f32x4){v[0], v[1], v[2], v[3]}; *(f32x4*)(o + 4) = (f32x4){v[4], v[5], v[6], v[7]}; }
                }
                sq += __shfl_xor(sq, 16); sq += __shfl_xor(sq, 32);
                if (fq == 0) atomicAdd(ss_out + r, sq);
            }
    }
};

struct EpiPre {
    static constexpr bool PERM = true;
    bf16_t* xbc; bf16_t* q; bf16_t* logf; bf16_t* v; const float* ss; const float* lbv; int grow0;
    __device__ __forceinline__ void operator()(const Acc& acc, const Unit& u, int wr, int wc, int fr, int fq) const {
        const int row0 = u.pm * BM + wr * 64 + fr, pn = u.pn;
        int mode, ld, cb; bf16_t* base;
        if (pn < 8) { mode = 0; base = xbc; ld = 2048; cb = pn * 256; }
        else if (pn < 12) { mode = 1; base = q; ld = 1024; cb = (pn - 8) * 256; }
        else if (pn < 20) { mode = 2; base = logf; ld = 2048; cb = (pn - 12) * 256; }
        else { mode = 0; base = v; ld = 1024; cb = (pn - 20) * 256; }
        const int col0 = cb + wc * 32 + 8 * fq;
#pragma unroll
        for (int ai = 0; ai < 2; ++ai)
#pragma unroll
            for (int m = 0; m < 4; ++m) {
                const int r = row0 + ai * HALF + m * 16;
                const float s = __builtin_amdgcn_rsqf(ss[grow0 + r] * (1.f / DM) + EPS);
#pragma unroll
                for (int bj = 0; bj < 2; ++bj) {
                    const int c = col0 + bj * HALF; float o[8];
#pragma unroll
                    for (int n = 0; n < 2; ++n)
#pragma unroll
                        for (int i = 0; i < 4; ++i) o[4 * n + i] = acc[ai][bj][m][n][i] * s;
                    u32x4 w;
                    if (mode == 0) w = pack8(o);
                    else if (mode == 1) {
#pragma unroll
                        for (int i = 0; i < 8; ++i) o[i] = fsilu(o[i]);
                        w = pack8(o);
                    } else {
                        const f32x4 l0 = *(const f32x4*)(lbv + c), l1 = *(const f32x4*)(lbv + c + 4);
                        const float lb[8] = {l0[0], l0[1], l0[2], l0[3], l1[0], l1[1], l1[2], l1[3]};
#pragma unroll
                        for (int i = 0; i < 8; ++i) { const float f = lb[i] + (1.f - lb[i]) * fsigmoid(o[i]); o[i] = __logf(f); }
                        w.x = pkh2(o[0], o[1]); w.y = pkh2(o[2], o[3]); w.z = pkh2(o[4], o[5]); w.w = pkh2(o[6], o[7]);
                    }
                    *(u32x4*)(base + (size_t)r * ld + c) = w;
                }
            }
    }
};

struct EpiPost {
    static constexpr bool PERM = true;
    bf16_t* out; const float* ss; int grow0; int gmode;
    __device__ __forceinline__ void operator()(const Acc& acc, const Unit& u, int wr, int wc, int fr, int fq) const {
        const int row0 = u.pm * BM + wr * 64 + fr, col0 = u.pn * 256 + wc * 32 + 8 * fq;
#pragma unroll
        for (int ai = 0; ai < 2; ++ai)
#pragma unroll
            for (int m = 0; m < 4; ++m) {
                const int r = row0 + ai * HALF + m * 16;
                const float s = __builtin_amdgcn_rsqf(ss[grow0 + r] * (1.f / DM) + EPS);
#pragma unroll
                for (int bj = 0; bj < 2; ++bj) {
                    const int c = col0 + bj * HALF; float o[8];
#pragma unroll
                    for (int n = 0; n < 2; ++n)
#pragma unroll
                        for (int i = 0; i < 4; ++i) { const float t = acc[ai][bj][m][n][i] * s; o[4 * n + i] = gmode ? fsigmoid(t) : fsilu(t); }
                    *(u32x4*)(out + (size_t)r * 2048 + c) = pack8(o);
                }
            }
    }
};

template <int FIRST>
struct EpiMerge {
    static constexpr bool PERM = true;
    bf16_t* merged; const bf16_t* gates; int rbase;
    __device__ __forceinline__ void operator()(const Acc& acc, const Unit& u, int wr, int wc, int fr, int fq) const {
        const int row0 = rbase + u.pm * BM + wr * 64 + fr, col0 = u.pn * BM + wc * 32 + 8 * fq;
#pragma unroll
        for (int ai = 0; ai < 2; ++ai)
#pragma unroll
            for (int m = 0; m < 4; ++m) {
                const int r = row0 + ai * HALF + m * 16;
#pragma unroll
                for (int bj = 0; bj < 2; ++bj) {
                    const int c = col0 + bj * HALF; float gt[8], o[8];
                    unpack8(*(const u32x4*)(gates + (size_t)r * 2048 + (FIRST ? 0 : 1024) + c), gt);
                    if (FIRST) {
#pragma unroll
                        for (int i = 0; i < 8; ++i) o[i] = 0.f;
                    } else unpack8(*(const u32x4*)(merged + (size_t)r * DM + c), o);
#pragma unroll
                    for (int n = 0; n < 2; ++n)
#pragma unroll
                        for (int i = 0; i < 4; ++i) o[4 * n + i] += gt[4 * n + i] * acc[ai][bj][m][n][i];
                    *(u32x4*)(merged + (size_t)r * DM + c) = pack8(o);
                }
            }
    }
};
}

__device__ __forceinline__ f32x4 sg16(const bf16_t* A, int lda, const bf16_t* Bt, int K, int lane) {
    const int r = lane & 15, q = lane >> 4;
    const bf16_t* ap = A + (size_t)r * lda + q * 8; const bf16_t* bp = Bt + (size_t)r * K + q * 8;
    f32x4 acc = {0.f, 0.f, 0.f, 0.f};
    for (int k = 0; k < K; k += 256) {
        bf16x8 a[8], b[8];
#pragma unroll
        for (int u = 0; u < 8; ++u) { a[u] = *(const bf16x8*)(ap + k + 32 * u); b[u] = *(const bf16x8*)(bp + k + 32 * u); }
#pragma unroll
        for (int u = 0; u < 8; ++u) acc = __builtin_amdgcn_mfma_f32_16x16x32_bf16(a[u], b[u], acc, 0, 0, 0);
    }
    return acc;
}

__device__ __forceinline__ void tr_item(const float* W, int N, int K, int n0, int k0, bf16_t* WT, int drow, const float* scale, LAS float* scr, int lane) {
#pragma unroll 8
    for (int i = 0; i < 32; ++i) { const int kk = 2 * i + (lane >> 5); float v = W[(size_t)(k0 + kk) * N + n0 + (lane & 31)]; if (scale) v *= scale[k0 + kk]; scr[kk * 33 + (lane & 31)] = v; }
    asm volatile("s_waitcnt lgkmcnt(0)" ::: "memory");
    const int c = lane & 7;
#pragma unroll
    for (int j = 0; j < 4; ++j) { const int n = (lane >> 3) + 8 * j; const LAS float* s = scr + (8 * c) * 33 + n;
        u32x4 o; o.x = pk2(s[0 * 33], s[1 * 33]); o.y = pk2(s[2 * 33], s[3 * 33]); o.z = pk2(s[4 * 33], s[5 * 33]); o.w = pk2(s[6 * 33], s[7 * 33]);
        *(u32x4*)(WT + (size_t)(drow + n) * K + k0 + 8 * c) = o; }
    asm volatile("s_waitcnt lgkmcnt(0)" ::: "memory");
}
__device__ __forceinline__ void tr_job(const float* W, int N, int K, int c0, int nc, bf16_t* WT, int d0, int mode, const float* scale, LAS float* scr, int gw, int ngw, int lane) {
    const int nblk = nc / 32, nitems = (K / 64) * nblk;
    for (int it = gw; it < nitems; it += ngw) {
        const int kb = it / nblk, nb = it % nblk, n0 = 32 * nb; int drow;
        if (mode == 0) drow = d0 + n0;
        else { const int j = n0 < DFF ? n0 : n0 - DFF; drow = (j / 128) * 256 + (j % 128) + (n0 < DFF ? 0 : 128); }
        tr_item(W, N, K, c0 + n0, 64 * kb, WT, drow, scale, scr, lane);
    }
}

constexpr int B_X1 = 0, B_X2 = 17408, B_VA = 35840, B_VB = 46080, B_ACS = 56320, B_R = 56576, B_C1 = 56832, B_C2 = 57344, B_E = 57856, BUFSZ = 58368;
constexpr int L_M = 2 * BUFSZ, L_S = L_M + 9216, L_OUT = L_S + 17408, SCAN_LDS_END = L_OUT + 9216;
constexpr int P136 = 136, P144 = 144, P80 = 80, P72 = 72;
typedef short v4i16_t __attribute__((ext_vector_type(4)));

#define LDF(base, row, col, pitch) (*(const LAS bf16x8*)(lds + (base) + ((row) * (pitch) + (col)) * 2))
__device__ __forceinline__ bf16x8 trfrag(LAS unsigned char* lds, int base, int pitch, int c, int ks, int lane) {
    const int g = lane >> 4, q = (lane & 15) >> 2, p = lane & 3;
    const int off = base + ((32 * ks + 8 * g + q) * pitch + 16 * c + 4 * p) * 2;
    const v4i16_t v0 = __builtin_amdgcn_ds_read_tr16_b64_v4i16((LAS v4i16_t*)(lds + off));
    const v4i16_t v1 = __builtin_amdgcn_ds_read_tr16_b64_v4i16((LAS v4i16_t*)(lds + off + 8 * pitch));
    return __builtin_shufflevector(v0, v1, 0, 1, 2, 3, 4, 5, 6, 7);
}

struct ScanItem {
    int kind;
    int head, dir, vh, nC;
    int nRun, outFrom;
    int row0;
    int grow0;
    const bf16_t* xc; const bf16_t* xcm; const float* dt; const float* dtm; float Aneg;
    const bf16_t* q; const bf16_t* logf; const bf16_t* v; const bf16_t* logfm; const bf16_t* vm; const float* hsc;
    bf16_t* out;
    int ocol;
};

template <int KIND>
__device__ __forceinline__ void scan_run(LAS unsigned char* lds, const ScanItem& it) {
    const int tid = fresh_tid(), lane = tid & 63, wv = __builtin_amdgcn_readfirstlane(tid >> 6), fr = lane & 15, fq = lane >> 4;
    const int nSteps = it.nRun + (it.dir == 0 ? 1 : 0);
    const int tr = wv >> 1, tc0 = (wv & 1) * 2, nt0 = (wv & 1) * 4;
    const int r0 = tid >> 4, ch = tid & 15, rxr = tid >> 3, xch = tid & 7;
    f32x4 S[4];
#pragma unroll
    for (int i = 0; i < 4; ++i) S[i] = (f32x4){0.f, 0.f, 0.f, 0.f};
    u32x4 ra[2], rb[2], rx; float dtv = 0.f, sc1 = 0.f, sc2 = 0.f, sce = 0.f;
    const u32x4 Z4 = {0u, 0u, 0u, 0u};

#define SCAN_LOAD(st) do { \
        const bool meta = (it.dir == 0 && (st) == 0); \
        const int c = it.dir == 0 ? (st) - 1 : it.nC - 1 - (st); \
        if (meta) { \
            if (KIND == 0) { const int cb = (it.head >> 2) * 128 + 8 * ch; \
                ra[0] = Z4; rb[0] = Z4; rx = Z4; ra[1] = Z4; rb[1] = Z4; dtv = 0.f; \
                if (r0 < 16) { ra[0] = *(const u32x4*)(it.xcm + (size_t)r0 * 2048 + 1536 + cb); rb[0] = *(const u32x4*)(it.xcm + (size_t)r0 * 2048 + 1024 + cb); } \
                if (rxr < 16) rx = *(const u32x4*)(it.xcm + (size_t)rxr * 2048 + it.head * 64 + 8 * xch); \
                if (lane < 16) dtv = it.dtm[lane * 32 + it.head]; } \
            else { ra[0] = Z4; ra[1] = Z4; rb[0] = Z4; rb[1] = Z4; rx = Z4; \
                if (lane < 16) { rb[0] = *(const u32x4*)(it.logfm + (size_t)lane * 2048 + it.head * 128 + 8 * wv); rb[1] = *(const u32x4*)(it.logfm + (size_t)lane * 2048 + it.head * 128 + 8 * (wv + 8)); \
                    rx = *(const u32x4*)(it.vm + (size_t)lane * 1024 + it.head * 128 + it.vh * 64 + 8 * wv); } } \
        } else { \
            const size_t g0 = (size_t)(it.row0 + 64 * c + (it.dir == 0 ? r0 : 63 - r0)), g1 = (size_t)(it.row0 + 64 * c + (it.dir == 0 ? r0 + 32 : 31 - r0)), gx = (size_t)(it.row0 + 64 * c + (it.dir == 0 ? rxr : 63 - rxr)); \
            if (KIND == 0) { const int cb = (it.head >> 2) * 128 + 8 * ch; \
                ra[0] = *(const u32x4*)(it.xc + g0 * 2048 + 1536 + cb); ra[1] = *(const u32x4*)(it.xc + g1 * 2048 + 1536 + cb); \
                rb[0] = *(const u32x4*)(it.xc + g0 * 2048 + 1024 + cb); rb[1] = *(const u32x4*)(it.xc + g1 * 2048 + 1024 + cb); \
                rx = *(const u32x4*)(it.xc + gx * 2048 + it.head * 64 + 8 * xch); \
                dtv = it.dt[(size_t)(it.grow0 + 64 * c + (it.dir == 0 ? lane : 63 - lane)) * 32 + it.dir * 16 + it.head]; } \
            else { const int cq = it.head * 128 + 8 * ch; \
                ra[0] = *(const u32x4*)(it.q + g0 * 1024 + cq); ra[1] = *(const u32x4*)(it.q + g1 * 1024 + cq); \
                rb[0] = *(const u32x4*)(it.logf + g0 * 2048 + it.dir * 1024 + cq); rb[1] = *(const u32x4*)(it.logf + g1 * 2048 + it.dir * 1024 + cq); \
                rx = *(const u32x4*)(it.v + gx * 1024 + it.head * 128 + it.vh * 64 + 8 * xch); \
                if (tid < 128) { const float* hp = it.hsc + (size_t)(it.row0 / 64 + c) * 6144 + it.dir * 1024 + it.head * 128 + tid; sc1 = hp[0]; sc2 = hp[2048]; sce = hp[4096]; } } \
        } } while (0)

#define SCAN_PREP(bo) do { \
        if (KIND == 0) { \
            const float a_ = dtv * it.Aneg; const float acs = wave_scan(a_, lane); const float aend = lane_bcast(acs, 63); \
            *(LAS u32x4*)(lds + (bo) + B_X1 + (r0 * P136 + 8 * ch) * 2) = ra[0]; *(LAS u32x4*)(lds + (bo) + B_X1 + ((r0 + 32) * P136 + 8 * ch) * 2) = ra[1]; \
            *(LAS u32x4*)(lds + (bo) + B_X2 + (r0 * P144 + 8 * ch) * 2) = rb[0]; *(LAS u32x4*)(lds + (bo) + B_X2 + ((r0 + 32) * P144 + 8 * ch) * 2) = rb[1]; \
            const int srcl = 8 * wv + (lane >> 3); \
            const float dtr = __shfl(dtv, srcl), acr = __shfl(acs, srcl), dte = __expf(aend - acr); \
            float x_[8], xe_[8]; unpack8(rx, x_); \
            _Pragma("unroll") for (int e = 0; e < 8; ++e) { x_[e] *= dtr; xe_[e] = x_[e] * dte; } \
            *(LAS u32x4*)(lds + (bo) + B_VA + (rxr * P80 + 8 * xch) * 2) = pack8(x_); \
            *(LAS u32x4*)(lds + (bo) + B_VB + (rxr * P80 + 8 * xch) * 2) = pack8(xe_); \
            if (wv == 0) { *(LAS float*)(lds + (bo) + B_ACS + lane * 4) = acs; *(LAS float*)(lds + (bo) + B_R + lane * 4) = __expf(acs); } \
            if (wv == 1 || wv == 2) { const int n_ = (wv - 1) * 64 + lane; *(LAS float*)(lds + (bo) + B_C1 + n_ * 4) = __expf(aend); *(LAS float*)(lds + (bo) + B_C2 + n_ * 4) = 1.f; *(LAS float*)(lds + (bo) + B_E + n_ * 4) = 1.f; } \
        } else { \
            *(LAS u32x4*)(lds + (bo) + B_X1 + (r0 * P136 + 8 * ch) * 2) = ra[0]; *(LAS u32x4*)(lds + (bo) + B_X1 + ((r0 + 32) * P136 + 8 * ch) * 2) = ra[1]; \
            *(LAS u32x4*)(lds + (bo) + B_X2 + (r0 * P144 + 8 * ch) * 2) = rb[0]; *(LAS u32x4*)(lds + (bo) + B_X2 + ((r0 + 32) * P144 + 8 * ch) * 2) = rb[1]; \
            *(LAS u32x4*)(lds + (bo) + B_VA + (rxr * P80 + 8 * xch) * 2) = rx; \
            if (tid < 128) { *(LAS float*)(lds + (bo) + B_C1 + tid * 4) = sc1; *(LAS float*)(lds + (bo) + B_C2 + tid * 4) = sc2; *(LAS float*)(lds + (bo) + B_E + tid * 4) = sce; } \
        } } while (0)

    bool pend = false; int pc = 0;
#define SCAN_FLUSH() do { if (pend) { const int _r = tid >> 3, _sg = tid & 7; const u32x4 _v = *(const LAS u32x4*)(lds + L_OUT + (_r * P72 + 8 * _sg) * 2); \
        const int _lr = it.dir == 0 ? _r : 63 - _r; *(u32x4*)(it.out + (size_t)(it.row0 + 64 * pc + _lr) * 1024 + it.ocol + 8 * _sg) = _v; } } while (0)

    SCAN_LOAD(0);
    if (KIND == 1 && it.dir == 0) {
#pragma unroll
        for (int i = 0; i < 2; ++i) { const int cv = wv + 8 * i;
            float lf[8], ke[8];
            lf[0] = hlo(rb[i].x); lf[1] = hhi(rb[i].x); lf[2] = hlo(rb[i].y); lf[3] = hhi(rb[i].y); lf[4] = hlo(rb[i].z); lf[5] = hhi(rb[i].z); lf[6] = hlo(rb[i].w); lf[7] = hhi(rb[i].w);
#pragma unroll
            for (int e = 0; e < 8; ++e) {
                const float b = wave_scan(lf[e], lane); const float ref = lane_bcast(b, 31), tot = lane_bcast(b, 63);
                ke[e] = (1.f - __expf(lf[e])) * __expf(ref - b);
                if (lane == 0) { *(LAS float*)(lds + B_C1 + (8 * cv + e) * 4) = __expf(tot); *(LAS float*)(lds + B_C2 + (8 * cv + e) * 4) = __expf(tot - ref); *(LAS float*)(lds + B_E + (8 * cv + e) * 4) = __expf(ref); }
            }
            *(LAS u32x4*)(lds + B_X1 + (lane * P136 + 8 * cv) * 2) = Z4;
            *(LAS u32x4*)(lds + B_X2 + (lane * P144 + 8 * cv) * 2) = pack8(ke);
        }
        *(LAS u32x4*)(lds + B_VA + (lane * P80 + 8 * wv) * 2) = rx;
    } else SCAN_PREP(0);
    if (nSteps > 1) SCAN_LOAD(1);

    for (int st = 0; st < nSteps; ++st) {
        const int bo = (st & 1) * BUFSZ;
        const int kreal = st - (it.dir == 0 ? 1 : 0);
        const bool do_out = kreal >= it.outFrom;
        __syncthreads();
        if (do_out) {
#pragma unroll
        for (int i = 0; i < 4; ++i) { const int n = 16 * (nt0 + i) + fr; const float e = *(const LAS float*)(lds + bo + B_E + n * 4);
#pragma unroll
            for (int j = 0; j < 4; j += 2) { const unsigned w = pk2(S[i][j] * e, S[i][j + 1] * e);
                *(LAS bf16_t*)(lds + L_S + ((16 * tr + 4 * fq + j) * P136 + n) * 2) = (bf16_t)(w & 0xffffu); *(LAS bf16_t*)(lds + L_S + ((16 * tr + 4 * fq + j + 1) * P136 + n) * 2) = (bf16_t)(w >> 16); } }
        }
        bf16x8 xa[4];
        if (do_out) {
            f32x4 g0 = {0.f, 0.f, 0.f, 0.f}, g1 = {0.f, 0.f, 0.f, 0.f};
#pragma unroll
            for (int kk = 0; kk < 4; ++kk) { xa[kk] = LDF(bo + B_X1, 16 * tr + fr, 32 * kk + 8 * fq, P136); const bf16x8 b0 = LDF(bo + B_X2, 16 * tc0 + fr, 32 * kk + 8 * fq, P144), b1 = LDF(bo + B_X2, 16 * (tc0 + 1) + fr, 32 * kk + 8 * fq, P144);
                g0 = __builtin_amdgcn_mfma_f32_16x16x32_bf16(xa[kk], b0, g0, 0, 0, 0); g1 = __builtin_amdgcn_mfma_f32_16x16x32_bf16(xa[kk], b1, g1, 0, 0, 0); }
#pragma unroll
            for (int h = 0; h < 2; ++h) { const int s = 16 * (tc0 + h) + fr; float as = 0.f; if (KIND == 0) as = *(const LAS float*)(lds + bo + B_ACS + s * 4);
                float gm[4];
#pragma unroll
                for (int j = 0; j < 4; ++j) { const int t = 16 * tr + 4 * fq + j; float g = h ? g1[j] : g0[j];
                    if (KIND == 0) { const float at = *(const LAS float*)(lds + bo + B_ACS + t * 4); g *= __expf(fminf(at - as, 0.f)); }
                    gm[j] = (s <= t) ? g : 0.f; }
#pragma unroll
                for (int j = 0; j < 4; j += 2) { const int t = 16 * tr + 4 * fq + j; const unsigned w = pk2(gm[j], gm[j + 1]);
                    *(LAS bf16_t*)(lds + L_M + (t * P72 + s) * 2) = (bf16_t)(w & 0xffffu); *(LAS bf16_t*)(lds + L_M + ((t + 1) * P72 + s) * 2) = (bf16_t)(w >> 16); } }
        }
        SCAN_FLUSH();
        if (do_out) __syncthreads();
        if (do_out) {
            f32x4 z0 = {0.f, 0.f, 0.f, 0.f}, z1 = {0.f, 0.f, 0.f, 0.f};
#pragma unroll
            for (int kk = 0; kk < 4; ++kk) { const bf16x8 b0 = LDF(L_S, 16 * tc0 + fr, 32 * kk + 8 * fq, P136), b1 = LDF(L_S, 16 * (tc0 + 1) + fr, 32 * kk + 8 * fq, P136);
                z0 = __builtin_amdgcn_mfma_f32_16x16x32_bf16(xa[kk], b0, z0, 0, 0, 0); z1 = __builtin_amdgcn_mfma_f32_16x16x32_bf16(xa[kk], b1, z1, 0, 0, 0); }
            if (KIND == 0) {
#pragma unroll
                for (int j = 0; j < 4; ++j) { const float r = *(const LAS float*)(lds + bo + B_R + (16 * tr + 4 * fq + j) * 4); z0[j] *= r; z1[j] *= r; } }
#pragma unroll
            for (int kk = 0; kk < 2; ++kk) { const bf16x8 a = LDF(L_M, 16 * tr + fr, 32 * kk + 8 * fq, P72), b0 = trfrag(lds, bo + B_VA, P80, tc0, kk, lane), b1 = trfrag(lds, bo + B_VA, P80, tc0 + 1, kk, lane);
                z0 = __builtin_amdgcn_mfma_f32_16x16x32_bf16(a, b0, z0, 0, 0, 0); z1 = __builtin_amdgcn_mfma_f32_16x16x32_bf16(a, b1, z1, 0, 0, 0); }
#pragma unroll
            for (int j = 0; j < 4; ++j) { const int t = 16 * tr + 4 * fq + j; const unsigned w = pk2(z0[j], z1[j]);
                *(LAS bf16_t*)(lds + L_OUT + (t * P72 + 16 * tc0 + fr) * 2) = (bf16_t)(w & 0xffffu); *(LAS bf16_t*)(lds + L_OUT + (t * P72 + 16 * (tc0 + 1) + fr) * 2) = (bf16_t)(w >> 16); }
        }
        pend = do_out; pc = it.dir == 0 ? st - 1 : it.nC - 1 - st;
        {
            f32x4 d[4];
#pragma unroll
            for (int i = 0; i < 4; ++i) d[i] = (f32x4){0.f, 0.f, 0.f, 0.f};
#pragma unroll
            for (int kk = 0; kk < 2; ++kk) { const bf16x8 a = trfrag(lds, bo + (KIND == 0 ? B_VB : B_VA), P80, tr, kk, lane);
#pragma unroll
                for (int i = 0; i < 4; ++i) { const bf16x8 b = trfrag(lds, bo + B_X2, P144, nt0 + i, kk, lane); d[i] = __builtin_amdgcn_mfma_f32_16x16x32_bf16(a, b, d[i], 0, 0, 0); } }
#pragma unroll
            for (int i = 0; i < 4; ++i) { const int n = 16 * (nt0 + i) + fr; const float c1 = *(const LAS float*)(lds + bo + B_C1 + n * 4), c2 = *(const LAS float*)(lds + bo + B_C2 + n * 4);
#pragma unroll
                for (int j = 0; j < 4; ++j) S[i][j] = c1 * S[i][j] + c2 * d[i][j]; }
        }
        if (st + 1 < nSteps) { SCAN_PREP(BUFSZ - bo); if (st + 2 < nSteps) SCAN_LOAD(st + 2); }
    }
    __syncthreads();
    SCAN_FLUSH();
    __syncthreads();
#undef SCAN_FLUSH
#undef SCAN_PREP
#undef SCAN_LOAD
}

#define XB_TMO      128
#define XB_XCNT(j)  (256  + 64 * (j))
#define XB_XSUB(j)  (1280 + 64 * (j))
#define XB_XGEN(j)  (2304 + 64 * (j))
#define XB_TOP      3328
#define XB_TOPGEN   3392
#define XCD_BAR_WORDS 3456
#define XB_SPIN_CAP (1u << 22)
__device__ __forceinline__ unsigned xb_ld(unsigned* p)              { return __hip_atomic_load(p, __ATOMIC_RELAXED, __HIP_MEMORY_SCOPE_AGENT); }
__device__ __forceinline__ unsigned xb_add(unsigned* p, unsigned v) { return __hip_atomic_fetch_add(p, v, __ATOMIC_RELAXED, __HIP_MEMORY_SCOPE_AGENT); }
__device__ __forceinline__ unsigned xb_xcc_id() { return (unsigned)__builtin_amdgcn_s_getreg((3 << 11) | 20) & 0xFu; }
#define XB_SPIN(cond, bar) do { unsigned _sp = 0; while (cond) { __builtin_amdgcn_s_sleep(1); \
    if ((++_sp & 255u) == 0u) { if (xb_ld(&(bar)[XB_TMO])) break; if (_sp > XB_SPIN_CAP) { atomicAdd(&(bar)[XB_TMO], 1u); break; } } } } while (0)
struct XcdBarrier { unsigned* bar; unsigned x; volatile LAS unsigned* st; };
__device__ __forceinline__ XcdBarrier xcd_barrier_post(unsigned* bar, volatile LAS unsigned* st) {
    XcdBarrier b; b.bar = bar; b.x = xb_xcc_id(); b.st = st;
    if (threadIdx.x == 0) (void)xb_add(&bar[XB_XCNT(b.x)], 1u);
    return b;
}
__device__ __forceinline__ void xcd_barrier_complete(unsigned* bar, unsigned x, unsigned& nloc, unsigned& nx) {
    const unsigned G = gridDim.x * gridDim.y * gridDim.z;
    unsigned sum, cnt, mine, sp = 0u;
    for (;;) {
        sum = 0u; cnt = 0u; mine = 0u;
#pragma unroll
        for (unsigned j = 0; j < 16; ++j) { const unsigned c = xb_ld(&bar[XB_XCNT(j)]); sum += c; cnt += (c > 0u) ? 1u : 0u; mine = (j == x) ? c : mine; }
        if (sum == G) break;
        __builtin_amdgcn_s_sleep(1);
        if ((++sp & 255u) == 0u) { if (xb_ld(&bar[XB_TMO])) break; if (sp > XB_SPIN_CAP) { atomicAdd(&bar[XB_TMO], 1u); break; } }
    }
    nloc = mine > 0u ? mine : 1u; nx = cnt > 0u ? cnt : 1u;
}
__device__ __forceinline__ void xcd_barrier(const XcdBarrier& b) {
    asm volatile("s_waitcnt vmcnt(0)" ::: "memory");
    __syncthreads();
    if (threadIdx.x == 0) {
        unsigned* bar = b.bar;
        __builtin_amdgcn_s_waitcnt(0);
        unsigned nloc = b.st[0], nx = b.st[1];
        if (nloc == 0u) { xcd_barrier_complete(bar, b.x, nloc, nx); b.st[0] = nloc; b.st[1] = nx; }
        const unsigned old = xb_add(&bar[XB_XSUB(b.x)], 1u);
        const unsigned gen = old / nloc;
        if (old + 1u == (gen + 1u) * nloc) {
            __builtin_amdgcn_fence(__ATOMIC_RELEASE, "agent");
            asm volatile("s_waitcnt vmcnt(0)" ::: "memory");
            const unsigned og = xb_add(&bar[XB_TOP], 1u);
            const unsigned tg = og / nx;
            if (og + 1u == (tg + 1u) * nx) xb_add(&bar[XB_TOPGEN], 1u);
            else XB_SPIN(xb_ld(&bar[XB_TOPGEN]) == tg, bar);
            __builtin_amdgcn_fence(__ATOMIC_ACQUIRE, "agent");
            xb_add(&bar[XB_XGEN(b.x)], 1u);
            asm volatile("s_waitcnt vmcnt(0)" ::: "memory");
        } else {
            XB_SPIN(xb_ld(&bar[XB_XGEN(b.x)]) == gen, bar);
            __builtin_amdgcn_fence(__ATOMIC_ACQUIRE, "agent");
            asm volatile("s_waitcnt vmcnt(0)" ::: "memory");
        }
    }
    __syncthreads();
}

struct Params { const float* in[23]; float* out; unsigned char* ws; };

constexpr int LDS_BST = 152576;
constexpr int LDS_BYTES = 152832;

__global__ void __launch_bounds__(512, 2) fwd_mega(Params P) {
    extern __shared__ __attribute__((aligned(16))) unsigned char lds_raw[];
    LAS unsigned char* lds = (LAS unsigned char*)lds_raw;
    cg::grid_group grid = cg::this_grid();
    const int G = gridDim.x, bx = blockIdx.x;
#define WSD unsigned char* ws = P.ws; asm volatile("" : "+s"(ws)); unsigned char* dob = (unsigned char*)P.out; asm volatile("" : "+s"(dob)); (void)dob
    volatile LAS unsigned* bst = (volatile LAS unsigned*)(lds + LDS_BST);
    if (threadIdx.x < 2) bst[threadIdx.x] = 0u;
    __syncthreads();
    (void)xcd_barrier_post((unsigned*)(P.ws + WS_BAR), bst);
#define GSYNC do { XcdBarrier _xb; _xb.bar = (unsigned*)(P.ws + WS_BAR); _xb.x = xb_xcc_id(); _xb.st = (volatile LAS unsigned*)(lds + LDS_BST); xcd_barrier(_xb); } while (0)
#define IDS WSD; const int tid = fresh_tid(), lane = tid & 63, wave = __builtin_amdgcn_readfirstlane(tid >> 6), gw = bx * 8 + wave, NGW = G * 8, gt = bx * 512 + tid, NGT = G * 512; (void)lane; (void)gw; (void)NGW; (void)gt; (void)NGT
#define x_p (P.in[0])
#define x_s (P.in[1])
#define meta (P.in[2])
#define SS0 ((float*)(ws + WS_SS0))
#define SS1 ((float*)(ws + WS_SS1))
#define SS2 ((float*)(ws + WS_SS2))
#define SS3 ((float*)(ws + WS_SS3))
#define SSM0 ((float*)(ws + WS_SSM0))
#define SSM1 ((float*)(ws + WS_SSM1))
#define LBV ((float*)(ws + WS_LBV))
#define HBM ((bf16_t*)(ws + M_HBM))
#define ACTM ((bf16_t*)(ws + M_ACTM))
#define XBCM ((bf16_t*)(ws + M_XBCM))
#define QM ((bf16_t*)(ws + M_QM))
#define LOGFM ((bf16_t*)(ws + M_LOGFM))
#define VM ((bf16_t*)(ws + M_VM))
#define DTM ((float*)(ws + M_DTM))
#define XCM ((bf16_t*)(ws + M_XCM))
#define DT ((float*)(ws + WS_DT))
#define WGU1 ((bf16_t*)(ws + WS_WGU1))
#define WD1 ((bf16_t*)(ws + WS_WD1))
#define WGU2 ((bf16_t*)(ws + WS_WGU2))
#define WD2 ((bf16_t*)(ws + WS_WD2))
#define WPRE ((bf16_t*)(ws + WS_WPRE))
#define WPOST ((bf16_t*)(ws + WS_WPOST))
#define WA ((bf16_t*)(ws + WS_WA))
#define WB ((bf16_t*)(ws + WS_WB))
#define WOUT ((bf16_t*)(ws + WS_WOUT))
#define WDT ((bf16_t*)(ws + WS_WDT))
#define HB ((bf16_t*)(ws + WS_HB))
#define ACT0 ((bf16_t*)(ws + WS_F))
#define ACT1 ((bf16_t*)dob)
#define QB ((bf16_t*)(ws + WS_QB))
#define VB ((bf16_t*)(ws + WS_VB))
#define ZG ((bf16_t*)(ws + WS_ZG))
#define GATES ((bf16_t*)(ws + WS_GATES))
#define SA QB
#define SB VB
#define XBC ((bf16_t*)(dob + DO_Y))
#define YF ((bf16_t*)(dob + DO_Y))
#define YB ((bf16_t*)(dob + DO_Y + 16 * MiB))
#define XC ((bf16_t*)(dob + DO_XC))
#define LOGF ((bf16_t*)(dob + DO_LOGF))
#define PARK GATES
#define GATES2 ((bf16_t*)(dob))
#define MERGED2 ((bf16_t*)(dob + 64 * MiB))
#define OF ((bf16_t*)(dob + DO_OF))
#define OB ((bf16_t*)(dob + DO_OB))
#define QE1 ((bf16_t*)(ws + WS_QE1))
#define HSC ((float*)(ws + WS_HSC))

    {
        IDS;
        LAS float* scr = (LAS float*)(lds + wave * 16384);
        tr_job(P.in[4], 2 * DFF, DM, 0, 2 * DFF, WGU1, 0, 1, P.in[3], scr, gw, NGW, lane);
        tr_job(P.in[5], DM, DFF, 0, DM, WD1, 0, 0, nullptr, scr, gw, NGW, lane);
        tr_job(P.in[20], 2 * DFF, DM, 0, 2 * DFF, WGU2, 0, 1, P.in[19], scr, gw, NGW, lane);
        tr_job(P.in[21], DM, DFF, 0, DM, WD2, 0, 0, nullptr, scr, gw, NGW, lane);
        tr_job(P.in[7], IN_COLS, DM, 1024, 2048, WPRE, 0, 0, P.in[6], scr, gw, NGW, lane);
        tr_job(P.in[7], IN_COLS, DM, 3104, 1024, WPRE, 2048, 0, P.in[6], scr, gw, NGW, lane);
        tr_job(P.in[7], IN_COLS, DM, 4128, 2048, WPRE, 3072, 0, P.in[6], scr, gw, NGW, lane);
        tr_job(P.in[7], IN_COLS, DM, 6176, 1024, WPRE, 5120, 0, P.in[6], scr, gw, NGW, lane);
        tr_job(P.in[7], IN_COLS, DM, 3072, 32, WDT, 0, 0, P.in[6], scr, gw, NGW, lane);
        tr_job(P.in[7], IN_COLS, DM, 0, 1024, WPOST, 0, 0, P.in[6], scr, gw, NGW, lane);
        tr_job(P.in[7], IN_COLS, DM, 7200, 1024, WPOST, 1024, 0, P.in[6], scr, gw, NGW, lane);
        tr_job(P.in[7], IN_COLS, DM, 8224, 2048, WPOST, 2048, 0, P.in[6], scr, gw, NGW, lane);
        tr_job(P.in[14], DM, DM, 0, DM, WA, 0, 0, P.in[13], scr, gw, NGW, lane);
        tr_job(P.in[17], DM, DM, 0, DM, WB, 0, 0, P.in[16], scr, gw, NGW, lane);
        tr_job(P.in[18], DM, DM, 0, DM, WOUT, 0, 0, nullptr, scr, gw, NGW, lane);
        for (int r = gw; r < NTOK + 16; r += NGW) {
            const bool ism = r >= NTOK; const int rr = ism ? r - NTOK : r;
            const float* xr = ism ? meta + (size_t)rr * DM : (rr < NP_ROWS ? x_p + (size_t)rr * DM : x_s + (size_t)(rr - NP_ROWS) * DM);
            bf16_t* orow = ism ? HBM + (size_t)rr * DM : HB + (size_t)rr * DM;
            float s = 0.f;
#pragma unroll
            for (int j = 0; j < 4; ++j) { const f32x4 v = *(const f32x4*)(xr + 4 * lane + 256 * j); s += (v[0] * v[0] + v[1] * v[1]) + (v[2] * v[2] + v[3] * v[3]);
                *(unsigned long long*)(orow + 4 * lane + 256 * j) = (unsigned long long)pk2(v[0], v[1]) | ((unsigned long long)pk2(v[2], v[3]) << 32); }
            s = wave_sum(s);
            if (lane == 0) { if (ism) SSM0[rr] = s; else SS0[rr] = s; }
        }
        for (int i = gt; i < NTOK; i += NGT) { SS1[i] = 0.f; SS2[i] = 0.f; SS3[i] = 0.f; }
        if (gt < 16) SSM1[gt] = 0.f;
        for (int i = gt; i < 2048; i += NGT) { const int d = i >> 10, w = i & 1023; const float* t = P.in[15]; LBV[i] = fsigmoid(t[d * 2048 + w] - t[d * 2048 + 1024 + w]); }
    }
    grid.sync();

    {
        IDS;
        if (gw < 176) {
            const int j0 = 16 * gw, brow = (j0 / 128) * 256 + (j0 % 128);
            const f32x4 ag = sg16(HBM, DM, WGU1 + (size_t)brow * DM, DM, lane), au = sg16(HBM, DM, WGU1 + (size_t)(brow + 128) * DM, DM, lane);
#pragma unroll
            for (int j = 0; j < 4; ++j) { const int row = 4 * (lane >> 4) + j; const float s = __builtin_amdgcn_rsqf(SSM0[row] * (1.f / DM) + EPS);
                ACTM[(size_t)row * DFF + j0 + (lane & 15)] = (bf16_t)f2bf(fsilu(ag[j] * s) * (au[j] * s)); }
        }
        pg8::Gemm g{HB, WGU1, NTOK, 2 * DFF, DM}; pg8::StaticOrder S; S.init(NTOK, 2 * DFF, G, bx);
        pg8::EpiGU E{ACT0, ACT1, NP_ROWS, SS0, 0};
        pg8::gemm_phase<pg8::EpiGU, pg8::StaticOrder, true, true>(lds, g, S, E);
    }
    GSYNC;
    {
        IDS;
        if (gw < 64) {
            const f32x4 a = sg16(ACTM, DFF, WD1 + (size_t)(16 * gw) * DFF, DFF, lane);
#pragma unroll
            for (int j = 0; j < 4; ++j) { const int row = 4 * (lane >> 4) + j, col = 16 * gw + (lane & 15); const float v = meta[(size_t)row * DM + col] + 0.5f * a[j];
                HBM[(size_t)row * DM + col] = (bf16_t)f2bf(v); float sq = v * v; sq += __shfl_xor(sq, 1); sq += __shfl_xor(sq, 2); sq += __shfl_xor(sq, 4); sq += __shfl_xor(sq, 8);
                if ((lane & 15) == 0) atomicAdd(SSM1 + row, sq); }
        }
#pragma unroll 1
        for (int h = 0; h < 2; ++h) {
            pg8::Gemm g{h ? ACT1 : ACT0, WD1, NP_ROWS, DM, DFF}; pg8::StaticOrder S; S.init(NP_ROWS, DM, G, bx);
            pg8::EpiRes<0, 0> E{x_p, x_s, HB, nullptr, 0.5f, SS1, h * NP_ROWS};
            pg8::gemm_phase<pg8::EpiRes<0, 0>, pg8::StaticOrder, true, true>(lds, g, S, E);
        }
    }
    GSYNC;

#if STAGE >= 2
#pragma unroll 1
    for (int grp = 0; grp < NGROUPS; ++grp) {
        const int grow0 = grp * GROUP_ROWS;
        const int nseq = grp < 2 ? 4 : 2, SL = grp < 2 ? 2048 : 4096;
        {
            IDS;
            if (grp == 0) {
                for (int t = gw; t < 384 + 2; t += NGW) {
                    if (t < 384) {
                        const int c0 = 16 * t; const f32x4 a = sg16(HBM, DM, WPRE + (size_t)c0 * DM, DM, lane);
#pragma unroll
                        for (int j = 0; j < 4; ++j) { const int row = 4 * (lane >> 4) + j, c = c0 + (lane & 15); const float v = a[j] * __builtin_amdgcn_rsqf(SSM1[row] * (1.f / DM) + EPS);
                            if (c < 2048) XBCM[row * 2048 + c] = (bf16_t)f2bf(v);
                            else if (c < 3072) QM[row * 1024 + c - 2048] = (bf16_t)f2bf(fsilu(v));
                            else if (c < 5120) { const float lb = LBV[c - 3072]; const float f = lb + (1.f - lb) * fsigmoid(v); LOGFM[row * 2048 + c - 3072] = (bf16_t)(pkh2(__logf(f), 0.f) & 0xffffu); }
                            else VM[row * 1024 + c - 5120] = (bf16_t)f2bf(v); }
                    } else {
                        const int c0 = 16 * (t - 384); const f32x4 a = sg16(HBM, DM, WDT + (size_t)c0 * DM, DM, lane);
#pragma unroll
                        for (int j = 0; j < 4; ++j) { const int row = 4 * (lane >> 4) + j, c = c0 + (lane & 15); const float v = a[j] * __builtin_amdgcn_rsqf(SSM1[row] * (1.f / DM) + EPS) + P.in[10][c];
                            DTM[row * 32 + c] = v > 15.f ? v : log1pf(__expf(v)); }
                    }
                }
            }
            for (int t = gw; t < 1024; t += NGW) {
                const int rt = t >> 1, c0 = 16 * (t & 1), r0 = grow0 + 16 * rt;
                const f32x4 a = sg16(HB + (size_t)r0 * DM, DM, WDT + (size_t)c0 * DM, DM, lane);
#pragma unroll
                for (int j = 0; j < 4; ++j) { const int row = r0 + 4 * (lane >> 4) + j, c = c0 + (lane & 15); const float v = a[j] * __builtin_amdgcn_rsqf(SS1[row] * (1.f / DM) + EPS) + P.in[10][c];
                    DT[(size_t)row * 32 + c] = v > 15.f ? v : log1pf(__expf(v)); }
            }
            pg8::Gemm g{HB + (size_t)grow0 * DM, WPRE, GROUP_ROWS, NPRE, DM}; pg8::StaticOrder S; S.init(GROUP_ROWS, NPRE, G, bx);
            pg8::EpiPre E{XBC, QB, LOGF, VB, SS1, LBV, grow0};
            pg8::gemm_phase<pg8::EpiPre, pg8::StaticOrder, true, true>(lds, g, S, E);
        }
        GSYNC;
        {
            IDS;
            const float* cw = P.in[8]; const float* cb = P.in[9];
#pragma unroll 1
            for (int pass = 0; pass < 2; ++pass) {
            if (((pass ^ (wave >> 2)) & 1) == 0) {
            for (int task = gt; task < (GROUP_ROWS / 16) * 256; task += NGT) {
                const int cgp = task & 255, rb = task >> 8, c = 8 * cgp, t0 = 16 * rb, seq0 = (t0 / SL) * SL, tl0 = t0 - seq0;
                float w[5][8], bias[8];
#pragma unroll
                for (int j = 0; j < 5; ++j) { const f32x4 a = *(const f32x4*)(cw + j * 2048 + c), b = *(const f32x4*)(cw + j * 2048 + c + 4); w[j][0] = a[0]; w[j][1] = a[1]; w[j][2] = a[2]; w[j][3] = a[3]; w[j][4] = b[0]; w[j][5] = b[1]; w[j][6] = b[2]; w[j][7] = b[3]; }
                { const f32x4 a = *(const f32x4*)(cb + c), b = *(const f32x4*)(cb + c + 4); bias[0] = a[0]; bias[1] = a[1]; bias[2] = a[2]; bias[3] = a[3]; bias[4] = b[0]; bias[5] = b[1]; bias[6] = b[2]; bias[7] = b[3]; }
                float win[5][8];
#define CONV_LD(dst, tau) do { const int _t = (tau); u32x4 _w = {0u, 0u, 0u, 0u}; \
                    if (_t < 0) _w = *(const u32x4*)(XBCM + (size_t)(16 + _t) * 2048 + c); else if (_t < SL) _w = *(const u32x4*)(XBC + (size_t)(seq0 + _t) * 2048 + c); \
                    unpack8(_w, dst); } while (0)
                CONV_LD(win[0], tl0 - 2); CONV_LD(win[1], tl0 - 1); CONV_LD(win[2], tl0); CONV_LD(win[3], tl0 + 1);
#pragma unroll
                for (int i = 0; i < 16; ++i) {
                    CONV_LD(win[4], tl0 + i + 2);
                    float o[8];
#pragma unroll
                    for (int e = 0; e < 8; ++e) { float a = bias[e];
#pragma unroll
                        for (int j = 0; j < 5; ++j) a += w[j][e] * win[j][e];
                        o[e] = fsilu(a); }
                    *(u32x4*)(XC + (size_t)(t0 + i) * 2048 + c) = pack8(o);
#pragma unroll
                    for (int j = 0; j < 4; ++j)
#pragma unroll
                        for (int e = 0; e < 8; ++e) win[j][e] = win[j + 1][e];
                }
            }
            for (int task = gt; task < nseq * 16 * 256; task += NGT) {
                const int cgp = task & 255, m = (task >> 8) & 15, sq = task >> 12, c = 8 * cgp, seq0 = sq * SL;
                const int sg = grp < 2 ? grp * 4 + sq : 8 + (grp - 2) * 2 + sq;
                float a[8];
                { const f32x4 b0 = *(const f32x4*)(cb + c), b1 = *(const f32x4*)(cb + c + 4); a[0] = b0[0]; a[1] = b0[1]; a[2] = b0[2]; a[3] = b0[3]; a[4] = b1[0]; a[5] = b1[1]; a[6] = b1[2]; a[7] = b1[3]; }
#pragma unroll
                for (int j = 0; j < 5; ++j) { const int mm = m + j - 2; if (mm < 0) continue;
                    const u32x4 wv_ = mm < 16 ? *(const u32x4*)(XBCM + (size_t)mm * 2048 + c) : *(const u32x4*)(XBC + (size_t)(seq0 + mm - 16) * 2048 + c);
                    float xv[8]; unpack8(wv_, xv); const f32x4 w0 = *(const f32x4*)(cw + j * 2048 + c), w1 = *(const f32x4*)(cw + j * 2048 + c + 4);
                    a[0] += w0[0] * xv[0]; a[1] += w0[1] * xv[1]; a[2] += w0[2] * xv[2]; a[3] += w0[3] * xv[3]; a[4] += w1[0] * xv[4]; a[5] += w1[1] * xv[5]; a[6] += w1[2] * xv[6]; a[7] += w1[3] * xv[7]; }
#pragma unroll
                for (int e = 0; e < 8; ++e) a[e] = fsilu(a[e]);
                *(u32x4*)(XCM + ((size_t)sg * 16 + m) * 2048 + c) = pack8(a);
            }
            } else {
            for (int unit = gw; unit < (GROUP_ROWS / 64) * 128; unit += NGW) {
                const int j = unit & 127, ch = unit >> 7; const size_t row = (size_t)ch * 64 + lane;
                const u32x4 qw = *(const u32x4*)(QB + row * 1024 + 8 * j), l0 = *(const u32x4*)(LOGF + row * 2048 + 8 * j), l1 = *(const u32x4*)(LOGF + row * 2048 + 1024 + 8 * j);
                float qv[8], x0[8], x1[8], qe0[8], ke0[8], qe1[8], ke1[8]; unpack8(qw, qv);
                x0[0] = hlo(l0.x); x0[1] = hhi(l0.x); x0[2] = hlo(l0.y); x0[3] = hhi(l0.y); x0[4] = hlo(l0.z); x0[5] = hhi(l0.z); x0[6] = hlo(l0.w); x0[7] = hhi(l0.w);
                x1[0] = hlo(l1.x); x1[1] = hhi(l1.x); x1[2] = hlo(l1.y); x1[3] = hhi(l1.y); x1[4] = hlo(l1.z); x1[5] = hhi(l1.z); x1[6] = hlo(l1.w); x1[7] = hhi(l1.w);
                float* hs = HSC + (size_t)ch * 6144 + 8 * j; float t0s = 0.f, r0s = 0.f, t1s = 0.f, r1s = 0.f;
#pragma unroll
                for (int e = 0; e < 8; ++e) {
                    const float p0 = wave_scan(x0[e], lane), tot0 = lane_bcast(p0, 63), ref0 = lane_bcast(p0, 31);
                    qe0[e] = qv[e] * __expf(p0 - ref0); ke0[e] = (1.f - __expf(x0[e])) * __expf(ref0 - p0);
                    const float p1 = wave_scan(x1[e], lane), tot1 = lane_bcast(p1, 63), b1 = tot1 - p1 + x1[e], ref1 = lane_bcast(b1, 32);
                    qe1[e] = qv[e] * __expf(b1 - ref1); ke1[e] = (1.f - __expf(x1[e])) * __expf(ref1 - b1);
                    if (lane == e) { t0s = tot0; r0s = ref0; t1s = tot1; r1s = ref1; }
                }
                if (lane < 8) { hs[lane] = __expf(t0s); hs[2048 + lane] = __expf(t0s - r0s); hs[4096 + lane] = __expf(r0s);
                                hs[1024 + lane] = __expf(t1s); hs[2048 + 1024 + lane] = __expf(t1s - r1s); hs[4096 + 1024 + lane] = __expf(r1s); }
                *(u32x4*)(QB + row * 1024 + 8 * j) = pack8(qe0); *(u32x4*)(QE1 + row * 1024 + 8 * j) = pack8(qe1);
                *(u32x4*)(LOGF + row * 2048 + 8 * j) = pack8(ke0); *(u32x4*)(LOGF + row * 2048 + 1024 + 8 * j) = pack8(ke1);
            }
            }
            }
#undef CONV_LD
        }
        GSYNC;
        {
            WSD;
            const int nbase = nseq * 64, nsplit = grp < 2 ? 1 : 2, nitems = nbase * nsplit;
#pragma unroll 1
            for (int item = bx; item < nitems; item += G) {
                const int late = item / nbase, ib = item % nbase;
                ScanItem it; const int half = nseq * 32; it.kind = ib / half; const int rem = ib % half, sq = rem / 32, r2 = rem % 32;
                const int sg = grp < 2 ? grp * 4 + sq : 8 + (grp - 2) * 2 + sq;
                it.nC = SL / 64; it.row0 = sq * SL; it.grow0 = grow0 + sq * SL;
                it.nRun = (nsplit == 2 && !late) ? it.nC / 2 : it.nC; it.outFrom = late ? it.nC / 2 : 0;
                it.xc = XC; it.xcm = XCM + (size_t)sg * 16 * 2048; it.dt = DT; it.dtm = DTM; it.q = QB; it.logf = LOGF; it.v = VB; it.logfm = LOGFM; it.vm = VM;
                if (it.kind == 0) { it.head = r2 >> 1; it.dir = r2 & 1; it.vh = 0; it.Aneg = -__expf(P.in[11][it.dir * 16 + it.head]); it.out = it.dir ? YB : YF; it.ocol = it.head * 64;
                    it.dtm = DTM + it.dir * 16; scan_run<0>(lds, it); }
                else { it.head = r2 >> 2; it.dir = (r2 >> 1) & 1; it.vh = r2 & 1; it.Aneg = 0.f; it.out = it.dir ? OB : OF; it.ocol = it.head * 128 + it.vh * 64;
                    it.logfm = LOGFM + it.dir * 1024; it.q = it.dir ? QE1 : QB; it.hsc = HSC; scan_run<1>(lds, it); }
            }
            int gp, cp;
            if (nitems < G) { gp = G - nitems; cp = bx - nitems; }
            else if (nsplit == 2 && nbase < G && nitems == G) { gp = nbase; cp = bx < nbase ? bx : -1; }
            else { gp = G; cp = bx; }
            pg8::Gemm g{HB + (size_t)grow0 * DM, WPOST, GROUP_ROWS, NPOST / 2, DM}; pg8::StaticOrder S; S.init(GROUP_ROWS, NPOST / 2, gp, cp);
            pg8::EpiPost E{ZG, SS1, grow0, 0};
            pg8::gemm_phase<pg8::EpiPost, pg8::StaticOrder, true, true>(lds, g, S, E);
        }
        GSYNC;
        {
            IDS;
            const float* dsk = P.in[12];
            bf16_t* const sa = (grp & 1) ? SA : PARK; bf16_t* const sb = (grp & 1) ? SB : PARK + (size_t)GROUP_ROWS * DM;
            for (int r = gw; r < GROUP_ROWS; r += NGW) {
                float ya[2][8], oa[2][8]; float ssq = 0.f;
#pragma unroll
                for (int j = 0; j < 2; ++j) { const int c = 8 * lane + 512 * j; float yf[8], yb[8], xs[8], zz[8];
                    unpack8(*(const u32x4*)(YF + (size_t)r * 1024 + c), yf); unpack8(*(const u32x4*)(YB + (size_t)r * 1024 + c), yb);
                    unpack8(*(const u32x4*)(XC + (size_t)r * 2048 + c), xs); unpack8(*(const u32x4*)(ZG + (size_t)r * 2048 + c), zz);
                    const float dk = dsk[c >> 6];
#pragma unroll
                    for (int e = 0; e < 8; ++e) { const float v = (yf[e] + yb[e] + dk * xs[e]) * zz[e]; ya[j][e] = v; ssq += v * v; } }
                ssq = wave_sum(ssq); const float rstd = __builtin_amdgcn_rsqf(ssq * (1.f / DM) + EPS);
#pragma unroll
                for (int j = 0; j < 2; ++j) { const int c = 8 * lane + 512 * j; float of[8], ob[8], hg[8]; float hs = 0.f;
                    unpack8(*(const u32x4*)(OF + (size_t)r * 1024 + c), of); unpack8(*(const u32x4*)(OB + (size_t)r * 1024 + c), ob); unpack8(*(const u32x4*)(ZG + (size_t)r * 2048 + 1024 + c), hg);
#pragma unroll
                    for (int e = 0; e < 8; ++e) { const float v = of[e] + ob[e]; oa[j][e] = v; hs += v * v; }
                    hs += __shfl_xor(hs, 1); hs += __shfl_xor(hs, 2); hs += __shfl_xor(hs, 4); hs += __shfl_xor(hs, 8);
                    const float hr = __builtin_amdgcn_rsqf(hs * (1.f / 128.f) + EPS);
#pragma unroll
                    for (int e = 0; e < 8; ++e) oa[j][e] = oa[j][e] * hr * hg[e]; }
#pragma unroll
                for (int j = 0; j < 2; ++j) { const int c = 8 * lane + 512 * j;
#pragma unroll
                    for (int e = 0; e < 8; ++e) ya[j][e] *= rstd;
                    *(u32x4*)(sa + (size_t)r * 1024 + c) = pack8(ya[j]); *(u32x4*)(sb + (size_t)r * 1024 + c) = pack8(oa[j]); }
            }
        }
        GSYNC;
        if (grp & 1) {
            const int prow0 = (grp - 1) * GROUP_ROWS;
            {
                WSD;
                pg8::Gemm g{HB + (size_t)prow0 * DM, WPOST + (size_t)(NPOST / 2) * DM, 2 * GROUP_ROWS, NPOST / 2, DM}; pg8::StaticOrder S; S.init(2 * GROUP_ROWS, NPOST / 2, G, bx);
                pg8::EpiPost E{GATES2, SS1, prow0, 1};
                pg8::gemm_phase<pg8::EpiPost, pg8::StaticOrder, true, true>(lds, g, S, E);
            }
            GSYNC;
            {
                WSD;
#pragma unroll 1
                for (int gi = 0; gi < 2; ++gi) {
                    const bf16_t* sa = gi ? SA : PARK; const bf16_t* sb = gi ? SB : PARK + (size_t)GROUP_ROWS * DM; const int c = (bx + gi * (G / 2)) % G;
                    { pg8::Gemm g{sa, WA, GROUP_ROWS, DM, DM}; pg8::StaticOrder S; S.init(GROUP_ROWS, DM, G, c); pg8::EpiMerge<1> E{MERGED2, GATES2, gi * GROUP_ROWS};
                      pg8::gemm_phase<pg8::EpiMerge<1>, pg8::StaticOrder, true, true>(lds, g, S, E); }
                    { pg8::Gemm g{sb, WB, GROUP_ROWS, DM, DM}; pg8::StaticOrder S; S.init(GROUP_ROWS, DM, G, c); pg8::EpiMerge<0> E{MERGED2, GATES2, gi * GROUP_ROWS};
                      pg8::gemm_phase<pg8::EpiMerge<0>, pg8::StaticOrder, true, true>(lds, g, S, E); }
                }
            }
            GSYNC;
            {
                WSD;
                pg8::Gemm g{MERGED2, WOUT, 2 * GROUP_ROWS, DM, DM}; pg8::StaticOrder S; S.init(2 * GROUP_ROWS, DM, G, bx);
                pg8::EpiRes<1, 0> E{nullptr, nullptr, HB, nullptr, 1.0f, SS2, prow0};
                pg8::gemm_phase<pg8::EpiRes<1, 0>, pg8::StaticOrder, true, true>(lds, g, S, E);
            }
            GSYNC;
        }
    }
#define SSF SS2
#else
#define SSF SS1
#endif

#pragma unroll 1
    for (int h = 0; h < 2; ++h) {
        {
            WSD;
            pg8::Gemm g{HB + (size_t)h * NP_ROWS * DM, WGU2, NP_ROWS, 2 * DFF, DM}; pg8::StaticOrder S; S.init(NP_ROWS, 2 * DFF, G, bx);
            pg8::EpiGU E{ACT0, ACT0, NP_ROWS, SSF, h * NP_ROWS};
            pg8::gemm_phase<pg8::EpiGU, pg8::StaticOrder, true, true>(lds, g, S, E);
        }
        GSYNC;
        {
            WSD;
            pg8::Gemm g{ACT0, WD2, NP_ROWS, DM, DFF}; pg8::StaticOrder S; S.init(NP_ROWS, DM, G, bx);
            pg8::EpiRes<1, 1> E{nullptr, nullptr, HB, P.out, 0.5f, SS3, h * NP_ROWS};
            pg8::gemm_phase<pg8::EpiRes<1, 1>, pg8::StaticOrder, true, true>(lds, g, S, E);
        }
        GSYNC;
    }
    {
        IDS;
        const float* fw = P.in[22];
        for (int r = gw; r < NTOK; r += NGW) {
            const float rstd = __builtin_amdgcn_rsqf(SS3[r] * (1.f / DM) + EPS); float* o = P.out + (size_t)r * DM;
#pragma unroll
            for (int j = 0; j < 4; ++j) { const int c = 4 * lane + 256 * j; f32x4 v = *(const f32x4*)(o + c); const f32x4 w = *(const f32x4*)(fw + c);
                v[0] *= rstd * w[0]; v[1] *= rstd * w[1]; v[2] *= rstd * w[2]; v[3] *= rstd * w[3]; *(f32x4*)(o + c) = v; }
        }
    }
}

extern "C" void kernel_launch(void* const* d_in, const int* in_sizes, int n_in, void* d_out, int out_size, void* d_ws, size_t ws_size, hipStream_t stream) {
    static int grid = 0;
    if (grid == 0) {
        if (n_in != 23 || out_size != NTOK * DM || ws_size < WS_END) { fprintf(stderr, "kernel_launch: unexpected shapes (n_in %d out %d ws %zu)\n", n_in, out_size, ws_size); grid = -1; return; }
        int dev = 0, cus = 0, per_cu = 0;
        hipGetDevice(&dev); hipDeviceGetAttribute(&cus, hipDeviceAttributeMultiprocessorCount, dev);
        hipFuncSetAttribute((const void*)fwd_mega, hipFuncAttributeMaxDynamicSharedMemorySize, LDS_BYTES);
        hipOccupancyMaxActiveBlocksPerMultiprocessor(&per_cu, (const void*)fwd_mega, 512, LDS_BYTES);
        if (per_cu < 1) { fprintf(stderr, "kernel_launch: occupancy query says %d blocks per CU\n", per_cu); grid = -1; return; }
        grid = cus;
    }
    if (grid < 0) return;
    Params p{};
    for (int i = 0; i < 23; ++i) p.in[i] = (const float*)d_in[i];
    p.out = (float*)d_out; p.ws = (unsigned char*)d_ws;
    (void)hipMemsetAsync((unsigned char*)d_ws + WS_BAR, 0, 16384, stream);
    void* args[] = {&p};
    hipError_t e = hipLaunchCooperativeKernel((const void*)fwd_mega, dim3(grid), dim3(512), args, LDS_BYTES, stream);
    if (e != hipSuccess) fprintf(stderr, "cooperative launch failed: %s (grid %d)\n", hipGetErrorString(e), grid);
}
```
